# Optimizing an MI355X kernel written in HIP

```python
import math
import jax
import jax.numpy as jnp
from jax import lax
import numpy as np

D_MODEL = 1024
BATCH = 32
SEQ = 2048
DEPTH = 2

GRID_W = 64
CTX_LEN = 256
EPS = 1e-6
ROPE_THETA = 10000.0
BLOCK_Q = 128
RET_CHUNK = 128
N_GROUPS = 4
GROUP_W = D_MODEL // N_GROUPS
MIX_W = N_GROUPS * GROUP_W

HY_W = GROUP_W
HY_ORDER = 2
HY_SHORT = 3
HY_EMB = 33
HY_BANDS = (HY_EMB - 1) // 2
HY_FFN = 64
HY_NFILT = HY_ORDER * 2 * HY_W
HY_DECAY_SHIFT = 0.05
HY_FAST_PCT = 0.3
HY_SLOW_PCT = 1.5
HY_TARGET = 1e-2
HY_COLS = (HY_ORDER + 1) * HY_W

MLA_HEADS = 4
MLA_Q_RANK = GROUP_W
MLA_KV_RANK = GROUP_W // 2
MLA_NOPE = 64
MLA_ROPE = 32
MLA_V = GROUP_W // MLA_HEADS
MLA_COLS = MLA_Q_RANK + MLA_KV_RANK + MLA_ROPE
MLA_SCALE = (MLA_NOPE + MLA_ROPE) ** -0.5

RET_HEADS = 4
RET_DK = GROUP_W // RET_HEADS
RET_DV = GROUP_W // RET_HEADS
RET_COLS = 2 * RET_HEADS * RET_DK + RET_HEADS * RET_DV + GROUP_W

GQA_HEADS = 4
GQA_KV_HEADS = 2
GQA_HD = GROUP_W // GQA_HEADS
GQA_COLS = (GQA_HEADS + 2 * GQA_KV_HEADS) * GQA_HD
GQA_SCALE = GQA_HD ** -0.5

IN_COLS = HY_COLS + MLA_COLS + RET_COLS + GQA_COLS
D_FF = ((8 * D_MODEL + 3 * 256 - 1) // (3 * 256)) * 256
F32 = jnp.float32

kernel_name = 'hymba_style_hybrid_dit_block'


def rms_norm(x, g):
    xf = x.astype(F32)
    y = xf * lax.rsqrt(jnp.mean(xf * xf, axis=-1, keepdims=True) + EPS)
    return (y * g.astype(F32)).astype(x.dtype)


def modulated_norm(x, g, shift, scale):
    return rms_norm(x, g) * (1.0 + scale) + shift


def ada_mod(cond, w, b):
    return jnp.split(jax.nn.silu(cond) @ w + b, 6, axis=-1)


def axial_rope_tables(rows, cols, dim):
    quarter = dim // 4
    inv = ROPE_THETA ** (-jnp.arange(quarter, dtype=F32) / quarter)
    ang = jnp.concatenate([rows.astype(F32)[:, None] * inv, cols.astype(F32)[:, None] * inv], axis=-1)
    return jnp.cos(ang), jnp.sin(ang)


def apply_rope(x, cos, sin):
    xf = x.astype(F32)
    x1, x2 = jnp.split(xf, 2, axis=-1)
    c = cos[None, :, None, :]
    s = sin[None, :, None, :]
    return jnp.concatenate([x1 * c - x2 * s, x2 * c + x1 * s], axis=-1).astype(x.dtype)


def block_attention(q, k, v, scale):
    b, lq, h, dk = q.shape
    g = k.shape[2]
    r = h // g
    dv = v.shape[-1]
    nb = lq // BLOCK_Q
    qb = q.reshape(b, nb, BLOCK_Q, g, r, dk).transpose(1, 0, 2, 3, 4, 5)

    def one_block(qblk):
        s = jnp.einsum('bqgrd,bkgd->bgrqk', qblk, k, preferred_element_type=F32) * scale
        p = jax.nn.softmax(s, axis=-1)
        return jnp.einsum('bgrqk,bkge->bqgre', p.astype(v.dtype), v)

    o = lax.map(one_block, qb)
    return o.transpose(1, 0, 2, 3, 4, 5).reshape(b, lq, h, dv)


def split_projection(p):
    sizes = (HY_COLS, MLA_Q_RANK, MLA_KV_RANK, MLA_ROPE, RET_COLS, GQA_COLS)
    offs = np.cumsum((0,) + sizes)
    return tuple(p[..., int(offs[i]):int(offs[i + 1])] for i in range(len(sizes)))


def short_conv(u, w, b):
    ch = u.shape[-1]
    y = lax.conv_general_dilated(u, w.astype(u.dtype)[:, None, :], window_strides=(1,),
                                 padding=((HY_SHORT // 2, HY_SHORT // 2),),
                                 dimension_numbers=('NWC', 'WIO', 'NWC'), feature_group_count=ch)
    return y + b.astype(u.dtype)


def hyena_filters(n_tok, w1, b1, w2, b2, w3, b3, freq, w4):
    t = jnp.linspace(0.0, 1.0, n_tok, dtype=F32)[:, None]
    wpos = 2.0 * math.pi * jnp.arange(n_tok, dtype=F32)[:, None] / n_tok
    fb = jnp.linspace(1e-4, HY_BANDS - 1, HY_BANDS, dtype=F32)[None, :]
    z = jnp.concatenate([t, jnp.cos(fb * wpos), -jnp.sin(fb * wpos)], axis=-1)
    fr = freq.astype(F32)
    hdn = jnp.sin(fr * (z @ w1.astype(F32) + b1.astype(F32)))
    hdn = jnp.sin(fr * (hdn @ w2.astype(F32) + b2.astype(F32)))
    hdn = jnp.sin(fr * (hdn @ w3.astype(F32) + b3.astype(F32)))
    filt = hdn @ w4.astype(F32)
    deltas = jnp.linspace(math.log(HY_TARGET) / HY_FAST_PCT, math.log(HY_TARGET) / HY_SLOW_PCT, HY_NFILT, dtype=F32)
    filt = filt * (jnp.exp(-t * jnp.abs(deltas)) + HY_DECAY_SHIFT)
    filt = filt.reshape(n_tok, HY_ORDER, 2, HY_W)
    k_full = jnp.concatenate([filt[:, :, 0], jnp.zeros((1, HY_ORDER, HY_W), F32), filt[:0:-1, :, 1]], axis=0)
    return k_full / jnp.sum(jnp.abs(k_full), axis=0, keepdims=True)


def fft_long_conv(u, kf, d):
    n_tok = u.shape[1]
    y = jnp.fft.irfft(jnp.fft.rfft(u, n=2 * n_tok, axis=1) * kf[None], n=2 * n_tok, axis=1)[:, :n_tok]
    return y + u * d.astype(F32)


def hyena_mixer(u, conv_w, conv_b, w1, b1, w2, b2, w3, b3, freq, w4, bias):
    n_tok = u.shape[1]
    uc = short_conv(u, conv_w, conv_b).astype(F32)
    v, x1, x2 = jnp.split(uc, 3, axis=-1)
    kf = jnp.fft.rfft(hyena_filters(n_tok, w1, b1, w2, b2, w3, b3, freq, w4), axis=0)
    zz = x1 * fft_long_conv(v, kf[:, 0], bias[0])
    y = x2 * fft_long_conv(zz, kf[:, 1], bias[1])
    return y.astype(u.dtype)


def mla_qkv(cq, ckv, kr, gq, wuq, gkv, wukv, rope):
    b, n_tok, _ = cq.shape
    q = (rms_norm(cq, gq) @ wuq).reshape(b, n_tok, MLA_HEADS, MLA_NOPE + MLA_ROPE)
    kv = (rms_norm(ckv, gkv) @ wukv).reshape(b, n_tok, MLA_HEADS, MLA_NOPE + MLA_V)
    q_nope, q_pe = q[..., :MLA_NOPE], q[..., MLA_NOPE:]
    k_nope, v = kv[..., :MLA_NOPE], kv[..., MLA_NOPE:]
    k_pe = kr[:, :, None, :]
    if rope is not None:
        q_pe = apply_rope(q_pe, *rope)
        k_pe = apply_rope(k_pe, *rope)
    q = jnp.concatenate([q_nope, q_pe], axis=-1)
    k = jnp.concatenate([k_nope, jnp.broadcast_to(k_pe, (b, n_tok, MLA_HEADS, MLA_ROPE))], axis=-1)
    return q, k, v


def retention_qkvg(u, rope):
    b, n_tok, _ = u.shape
    qk = RET_HEADS * RET_DK
    q = u[..., :qk].reshape(b, n_tok, RET_HEADS, RET_DK)
    k = u[..., qk:2 * qk].reshape(b, n_tok, RET_HEADS, RET_DK) * (RET_DK ** -0.5)
    v = u[..., 2 * qk:2 * qk + RET_HEADS * RET_DV].reshape(b, n_tok, RET_HEADS, RET_DV)
    g = u[..., 2 * qk + RET_HEADS * RET_DV:]
    if rope is not None:
        q = apply_rope(q, *rope)
        k = apply_rope(k, *rope)
    return q, k, v, g


def retention_chunked(q, k, v, log_g, state0):
    b, n_tok, h, _ = q.shape
    dv = v.shape[-1]
    n_chunks = n_tok // RET_CHUNK
    idx = jnp.arange(RET_CHUNK, dtype=F32)
    diff = idx[:, None] - idx[None, :]
    inner = jnp.where(diff >= 0, jnp.exp(log_g[:, None, None] * jnp.maximum(diff, 0.0)), 0.0)
    q_dec = jnp.exp((idx[:, None] + 1.0) * log_g[None, :])[None, :, :, None]
    k_dec = jnp.exp((RET_CHUNK - 1.0 - idx[:, None]) * log_g[None, :])[None, :, :, None]
    c_dec = jnp.exp(RET_CHUNK * log_g)[None, :, None, None]

    def chunks(t):
        return t.astype(F32).reshape(b, n_chunks, RET_CHUNK, h, t.shape[-1]).transpose(1, 0, 2, 3, 4)

    def step(state, qkv):
        qc, kc, vc = qkv
        s = jnp.einsum('bihd,bjhd->bhij', qc, kc) * inner
        o = jnp.einsum('bhij,bjhe->bihe', s, vc) + jnp.einsum('bihd,bhde->bihe', qc, state) * q_dec
        state = state * c_dec + jnp.einsum('bjhd,bjhe->bhde', kc * k_dec, vc)
        return state, o

    state, o = lax.scan(step, state0, (chunks(q), chunks(k), chunks(v)))
    return o.transpose(1, 0, 2, 3, 4).reshape(b, n_tok, h, dv), state


def retention_final_state(k, v, log_g):
    n_tok = k.shape[1]
    w = jnp.exp((n_tok - 1.0 - jnp.arange(n_tok, dtype=F32))[:, None] * log_g[None, :])
    return jnp.einsum('bjhd,bjhe,jh->bhde', k.astype(F32), v.astype(F32), w)


def bidir_retention(q, k, v, log_g, s_f0, s_b0):
    o_f, s_f = retention_chunked(q, k, v, log_g[0], s_f0)
    o_b, s_b = retention_chunked(q[:, ::-1], k[:, ::-1], v[:, ::-1], log_g[1], s_b0)
    return o_f + o_b[:, ::-1], s_f, s_b


def retention_output(o, g, norm_g):
    b, n_tok = o.shape[0], o.shape[1]
    o = rms_norm(o, norm_g.reshape(RET_HEADS, RET_DV)).reshape(b, n_tok, GROUP_W)
    return (o * jax.nn.silu(g.astype(F32))).astype(g.dtype)


def gqa_qkv(u, gq, gk, rope):
    b, n_tok, _ = u.shape
    nq = GQA_HEADS * GQA_HD
    nk = GQA_KV_HEADS * GQA_HD
    q = rms_norm(u[..., :nq].reshape(b, n_tok, GQA_HEADS, GQA_HD), gq)
    k = rms_norm(u[..., nq:nq + nk].reshape(b, n_tok, GQA_KV_HEADS, GQA_HD), gk)
    v = u[..., nq + nk:].reshape(b, n_tok, GQA_KV_HEADS, GQA_HD)
    if rope is not None:
        q = apply_rope(q, *rope)
        k = apply_rope(k, *rope)
    return q, k, v


def merge_groups(ya, yb, yc, yd, g_out, w_out):
    b, n_tok = ya.shape[0], ya.shape[1]
    y = jnp.stack([ya, yb.astype(ya.dtype), yc.astype(ya.dtype), yd.astype(ya.dtype)], axis=-2)
    y = rms_norm(y, g_out.reshape(N_GROUPS, GROUP_W)).reshape(b, n_tok, MIX_W)
    return y @ w_out


def swiglu(h, w_in, w_out):
    a, g = jnp.split(h @ w_in, 2, axis=-1)
    return (jax.nn.silu(a) * g) @ w_out


def setup_inputs(seed: int = 0) -> dict:
    key = jax.random.key(seed)
    keys = iter(jax.random.split(key, 48))

    def nrm(shape, scale):
        return jax.random.normal(next(keys), shape, F32) * scale

    def gain(shape):
        return 1.0 + nrm(shape, 0.02)

    ret_logit = jnp.asarray(np.log(2.0 ** (5.0 + np.arange(RET_HEADS)) - 1.0), F32)
    return {
        'x': nrm((BATCH, SEQ, D_MODEL), 1.0),
        'c': nrm((BATCH, D_MODEL), 1.0),
        'ctx': nrm((BATCH, CTX_LEN, D_MODEL), 1.0),
        'c_ctx': nrm((D_MODEL,), 1.0),
        'w_mod': nrm((DEPTH, D_MODEL, 6 * D_MODEL), 0.5 * D_MODEL ** -0.5),
        'b_mod': nrm((DEPTH, 6 * D_MODEL), 0.01),
        'norm_attn_g': gain((DEPTH, D_MODEL)),
        'norm_ffn_g': gain((DEPTH, D_MODEL)),
        'w_in': nrm((DEPTH, D_MODEL, IN_COLS), D_MODEL ** -0.5),
        'hy_conv_w': nrm((DEPTH, HY_SHORT, HY_COLS), HY_SHORT ** -0.5),
        'hy_conv_b': nrm((DEPTH, HY_COLS), 0.01),
        'hy_w1': nrm((DEPTH, HY_EMB, HY_FFN), HY_EMB ** -0.5),
        'hy_b1': nrm((DEPTH, HY_FFN), 0.1),
        'hy_w2': nrm((DEPTH, HY_FFN, HY_FFN), HY_FFN ** -0.5),
        'hy_b2': nrm((DEPTH, HY_FFN), 0.1),
        'hy_w3': nrm((DEPTH, HY_FFN, HY_FFN), HY_FFN ** -0.5),
        'hy_b3': nrm((DEPTH, HY_FFN), 0.1),
        'hy_freq': 1.0 + nrm((DEPTH, HY_FFN), 0.1),
        'hy_w4': nrm((DEPTH, HY_FFN, HY_NFILT), HY_FFN ** -0.5),
        'hy_bias': nrm((DEPTH, HY_ORDER, HY_W), 0.1),
        'mla_q_norm_g': gain((DEPTH, MLA_Q_RANK)),
        'mla_w_uq': nrm((DEPTH, MLA_Q_RANK, MLA_HEADS * (MLA_NOPE + MLA_ROPE)), MLA_Q_RANK ** -0.5),
        'mla_kv_norm_g': gain((DEPTH, MLA_KV_RANK)),
        'mla_w_ukv': nrm((DEPTH, MLA_KV_RANK, MLA_HEADS * (MLA_NOPE + MLA_V)), MLA_KV_RANK ** -0.5),
        'ret_decay': ret_logit + nrm((DEPTH, 2, RET_HEADS), 0.05),
        'ret_norm_g': gain((DEPTH, RET_HEADS * RET_DV)),
        'gqa_q_norm_g': gain((DEPTH, GQA_HD)),
        'gqa_k_norm_g': gain((DEPTH, GQA_HD)),
        'out_norm_g': gain((DEPTH, MIX_W)),
        'w_out': nrm((DEPTH, MIX_W, D_MODEL), MIX_W ** -0.5),
        'w_ffn_in': nrm((DEPTH, D_MODEL, 2 * D_FF), D_MODEL ** -0.5),
        'w_ffn_out': nrm((DEPTH, D_FF, D_MODEL), D_FF ** -0.5),
        'final_norm_g': gain((D_MODEL,)),
    }


def reference(x, c, ctx, c_ctx, w_mod, b_mod, norm_attn_g, norm_ffn_g, w_in, hy_conv_w, hy_conv_b,
              hy_w1, hy_b1, hy_w2, hy_b2, hy_w3, hy_b3, hy_freq, hy_w4, hy_bias,
              mla_q_norm_g, mla_w_uq, mla_kv_norm_g, mla_w_ukv, ret_decay, ret_norm_g,
              gqa_q_norm_g, gqa_k_norm_g, out_norm_g, w_out, w_ffn_in, w_ffn_out, final_norm_g):
    b, n_lat = x.shape[0], x.shape[1]
    ROWS = n_lat // GRID_W
    rows = jnp.repeat(jnp.arange(ROWS, dtype=jnp.int32), GRID_W)
    cols = jnp.tile(jnp.arange(GRID_W, dtype=jnp.int32), ROWS)
    rope_mla = axial_rope_tables(rows, cols, MLA_ROPE)
    rope_ret = axial_rope_tables(rows, cols, RET_DK)
    rope_gqa = axial_rope_tables(rows, cols, GQA_HD)
    zero_state = jnp.zeros((b, RET_HEADS, RET_DK, RET_DV), F32)

    xl, xc = x, ctx
    for l in range(DEPTH):
        update_ctx = l < DEPTH - 1
        sh_a, sc_a, g_a, sh_f, sc_f, g_f = ada_mod(c[:, None, :], w_mod[l], b_mod[l])
        csh_a, csc_a, cg_a, csh_f, csc_f, cg_f = ada_mod(c_ctx[None, None, :], w_mod[l], b_mod[l])
        pl = modulated_norm(xl, norm_attn_g[l], sh_a, sc_a) @ w_in[l]
        pc = modulated_norm(xc, norm_attn_g[l], csh_a, csc_a) @ w_in[l]
        hy_l, cq_l, ckv_l, kr_l, ret_in_l, gqa_in_l = split_projection(pl)
        hy_c, cq_c, ckv_c, kr_c, ret_in_c, gqa_in_c = split_projection(pc)

        hy_args = (hy_conv_w[l], hy_conv_b[l], hy_w1[l], hy_b1[l], hy_w2[l], hy_b2[l],
                   hy_w3[l], hy_b3[l], hy_freq[l], hy_w4[l], hy_bias[l])
        ya_l = hyena_mixer(hy_l, *hy_args)

        mla_args = (mla_q_norm_g[l], mla_w_uq[l], mla_kv_norm_g[l], mla_w_ukv[l])
        q_l, k_l, v_l = mla_qkv(cq_l, ckv_l, kr_l, *mla_args, rope_mla)
        q_c, k_c, v_c = mla_qkv(cq_c, ckv_c, kr_c, *mla_args, None)
        yb_l = block_attention(q_l, jnp.concatenate([k_c, k_l], axis=1), jnp.concatenate([v_c, v_l], axis=1),
                               MLA_SCALE).reshape(b, n_lat, GROUP_W)

        log_g = jax.nn.log_sigmoid(ret_decay[l].astype(F32))
        rq_l, rk_l, rv_l, rg_l = retention_qkvg(ret_in_l, rope_ret)
        rq_c, rk_c, rv_c, rg_c = retention_qkvg(ret_in_c, None)
        if update_ctx:
            ro_c, s_f, s_b = bidir_retention(rq_c, rk_c, rv_c, log_g, zero_state, zero_state)
        else:
            s_f = retention_final_state(rk_c, rv_c, log_g[0])
            s_b = retention_final_state(rk_c[:, ::-1], rv_c[:, ::-1], log_g[1])
        ro_l, _, _ = bidir_retention(rq_l, rk_l, rv_l, log_g, s_f, s_b)
        yc_l = retention_output(ro_l, rg_l, ret_norm_g[l])

        gq_l, gk_l, gv_l = gqa_qkv(gqa_in_l, gqa_q_norm_g[l], gqa_k_norm_g[l], rope_gqa)
        gq_c, gk_c, gv_c = gqa_qkv(gqa_in_c, gqa_q_norm_g[l], gqa_k_norm_g[l], None)
        yd_l = block_attention(gq_l, jnp.concatenate([gk_c, gk_l], axis=1), jnp.concatenate([gv_c, gv_l], axis=1),
                               GQA_SCALE).reshape(b, n_lat, GROUP_W)

        xl = xl + g_a * merge_groups(ya_l, yb_l, yc_l, yd_l, out_norm_g[l], w_out[l])
        xl = xl + g_f * swiglu(modulated_norm(xl, norm_ffn_g[l], sh_f, sc_f), w_ffn_in[l], w_ffn_out[l])

        if update_ctx:
            n_ctx = xc.shape[1]
            ya_c = hyena_mixer(hy_c, *hy_args)
            yb_c = block_attention(q_c, k_c, v_c, MLA_SCALE).reshape(b, n_ctx, GROUP_W)
            yc_c = retention_output(ro_c, rg_c, ret_norm_g[l])
            yd_c = block_attention(gq_c, gk_c, gv_c, GQA_SCALE).reshape(b, n_ctx, GROUP_W)
            xc = xc + cg_a * merge_groups(ya_c, yb_c, yc_c, yd_c, out_norm_g[l], w_out[l])
            xc = xc + cg_f * swiglu(modulated_norm(xc, norm_ffn_g[l], csh_f, csc_f), w_ffn_in[l], w_ffn_out[l])

    return rms_norm(xl, final_norm_g)
```

```cpp
#include <hip/hip_runtime.h>
#include <hip/hip_cooperative_groups.h>
#include <cstdio>
#include <cstdint>
namespace cg = cooperative_groups;

typedef unsigned short bf16_t;
typedef short bf16x8 __attribute__((ext_vector_type(8)));
typedef short s16x4 __attribute__((ext_vector_type(4)));
typedef float f32x4 __attribute__((ext_vector_type(4)));
typedef float f32x16 __attribute__((ext_vector_type(16)));
typedef unsigned u32x4 __attribute__((ext_vector_type(4)));
typedef unsigned u32x2 __attribute__((ext_vector_type(2)));
#define LAS __attribute__((address_space(3)))

constexpr int DM = 1024, NB = 32, SEQ = 2048, NCTX = 256, RPB = 2304, T = NB * RPB;
constexpr int INC = 2720, DFF = 2816;
constexpr int LDPA = 768, LDPB = 1952, LDU = 1024;
constexpr int C_CQ = 0, C_CKV = 256, C_KR = 384, C_RQ = 416, C_RK = 672, C_RV = 928, C_RG = 1184, C_GQ = 1440, C_GK = 1696, C_GV = 1824;
constexpr float EPS = 1e-6f;
constexpr int LDS_TP = 131072 + 64, LDS_BYTES = LDS_TP + 8 * 2560;

constexpr size_t al256(size_t x) { return (x + 255) / 256 * 256; }
constexpr size_t WS_WIN = 0;
constexpr size_t WS_WOUT = WS_WIN + al256((size_t)2 * 2816 * 1024 * 2);
constexpr size_t WS_WFI = WS_WOUT + al256((size_t)2 * 1024 * 1024 * 2);
constexpr size_t WS_WFO = WS_WFI + al256((size_t)2 * 5632 * 1024 * 2);
constexpr size_t WS_WUP = WS_WFO + al256((size_t)2 * 1024 * 2816 * 2);
constexpr size_t WS_MOD = WS_WUP + al256((size_t)2 * 1024 * 512 * 2);
constexpr size_t WS_NORM = WS_MOD + al256((size_t)2 * 33 * 6144 * 4);
constexpr size_t WS_BAR = WS_NORM + al256((size_t)2 * 2 * 512 * 4);
constexpr size_t WS_KREVL = WS_BAR + al256((size_t)3456 * 4);
constexpr size_t WS_KREVC = WS_KREVL + al256((size_t)2 * 512 * 4096 * 2);
constexpr size_t WS_XS = WS_KREVC + al256((size_t)2 * 512 * 512 * 2);
constexpr size_t WS_XA = WS_XS + al256((size_t)T * 1024 * 4);
constexpr size_t WS_PB = WS_XA + al256((size_t)T * 1024 * 2);
constexpr size_t WS_PA = WS_PB + al256((size_t)T * LDPB * 2);
constexpr size_t WS_VT = WS_PA + al256((size_t)T * LDPA * 2);
constexpr size_t WS_X1T = WS_VT + al256((size_t)T * 256 * 2);
constexpr size_t WS_X2T = WS_X1T + al256((size_t)T * 256 * 2);
constexpr size_t WS_RST = WS_X2T + al256((size_t)T * 256 * 2);
constexpr size_t WS_SSQ = WS_RST + al256((size_t)NB * 4 * 2 * 8 * 4096 * 2);
constexpr size_t WS_SSK = WS_SSQ + al256((size_t)T * 4 * 4);
constexpr size_t WS_END = WS_SSK + al256((size_t)T * 4 * 4);
constexpr size_t WS_ZZT = WS_PA;
constexpr size_t WS_YAT = WS_PA + al256((size_t)T * 256 * 2);
constexpr size_t WS_H = WS_PB;
static_assert(WS_H + (size_t)T * DFF * 2 <= WS_RST, "H alias");
static_assert(WS_END <= ((size_t)1 << 30), "workspace over 1 GiB");
static_assert(WS_X1T == WS_VT + (size_t)T * 256 * 2 && WS_X2T == WS_X1T + (size_t)T * 256 * 2, "VT|X1T|X2T consecutive");

struct Params { const float* in[33]; float* out; unsigned char* ws; };

__device__ __forceinline__ float bf2f(bf16_t v) { return __uint_as_float(((unsigned)v) << 16); }
__device__ __forceinline__ bf16_t f2bf(float f) { unsigned u = __float_as_uint(f); u += 0x7FFFu + ((u >> 16) & 1u); return (bf16_t)(u >> 16); }
__device__ __forceinline__ unsigned cvtpk(float lo, float hi) { unsigned r; asm volatile("v_cvt_pk_bf16_f32 %0, %1, %2" : "=v"(r) : "v"(lo), "v"(hi)); return r; }
__device__ __forceinline__ float wsum(float v) { for (int o = 32; o >= 1; o >>= 1) v += __shfl_xor(v, o); return v; }
__device__ __forceinline__ float gsum16(float v) { for (int o = 8; o >= 1; o >>= 1) v += __shfl_xor(v, o); return v; }
__device__ __forceinline__ int opaque_tid() { int t = threadIdx.x; asm volatile("" : "+v"(t)); return t; }
__device__ __forceinline__ float lo16(unsigned w) { return __uint_as_float(w << 16); }
__device__ __forceinline__ float hi16(unsigned w) { return __uint_as_float(w & 0xffff0000u); }


#define XB_TMO      128
#define XB_XCNT(j)  (256  + 64 * (j))
#define XB_XSUB(j)  (1280 + 64 * (j))
#define XB_XGEN(j)  (2304 + 64 * (j))
#define XB_TOP      3328
#define XB_TOPGEN   3392
#define XCD_BAR_WORDS 3456
#define XB_SPIN_CAP (1u << 22)
__device__ __forceinline__ unsigned xb_ld(unsigned* p)              { return __hip_atomic_load(p, __ATOMIC_RELAXED, __HIP_MEMORY_SCOPE_AGENT); }
__device__ __forceinline__ unsigned xb_add(unsigned* p, unsigned v) { return __hip_atomic_fetch_add(p, v, __ATOMIC_RELAXED, __HIP_MEMORY_SCOPE_AGENT); }
__device__ __forceinline__ unsigned xb_xcc_id() { return (unsigned)__builtin_amdgcn_s_getreg((3 << 11) | 20) & 0xFu; }
#define XB_SPIN(cond, bar) do { unsigned _sp = 0; while (cond) { __builtin_amdgcn_s_sleep(1); \
    if ((++_sp & 255u) == 0u) { if (xb_ld(&(bar)[XB_TMO])) break; if (_sp > XB_SPIN_CAP) { atomicAdd(&(bar)[XB_TMO], 1u); break; } } } } while (0)
struct XcdBarrier { unsigned* bar; unsigned x; volatile LAS unsigned* st; };
__device__ __forceinline__ XcdBarrier xcd_barrier_post(unsigned* bar, volatile LAS unsigned* st) {
    XcdBarrier b; b.bar = bar; b.x = xb_xcc_id(); b.st = st;
    if (threadIdx.x == 0) (void)xb_add(&bar[XB_XCNT(b.x)], 1u);
    return b;
}
__device__ __forceinline__ void xcd_barrier_complete(unsigned* bar, unsigned x, unsigned& nloc, unsigned& nx) {
    const unsigned G = gridDim.x * gridDim.y * gridDim.z;
    unsigned sum, cnt, mine, sp = 0u;
    for (;;) {
        sum = 0u; cnt = 0u; mine = 0u;
#pragma unroll
        for (unsigned j = 0; j < 16; ++j) { const unsigned c = xb_ld(&bar[XB_XCNT(j)]); sum += c; cnt += (c > 0u) ? 1u : 0u; mine = (j == x) ? c : mine; }
        if (sum == G) break;
        __builtin_amdgcn_s_sleep(1);
        if ((++sp & 255u) == 0u) { if (xb_ld(&bar[XB_TMO])) break; if (sp > XB_SPIN_CAP) { atomicAdd(&bar[XB_TMO], 1u); break; } }
    }
    nloc = mine > 0u ? mine : 1u; nx = cnt > 0u ? cnt : 1u;
}
__device__ __forceinline__ void xcd_barrier(const XcdBarrier& b) {
    asm volatile("s_waitcnt vmcnt(0)" ::: "memory");
    __syncthreads();
    if (threadIdx.x == 0) {
        unsigned* bar = b.bar;
        __builtin_amdgcn_s_waitcnt(0);
        unsigned nloc = b.st[0], nx = b.st[1];
        if (nloc == 0u) { xcd_barrier_complete(bar, b.x, nloc, nx); b.st[0] = nloc; b.st[1] = nx; }
        const unsigned old = xb_add(&bar[XB_XSUB(b.x)], 1u);
        const unsigned gen = old / nloc;
        if (old + 1u == (gen + 1u) * nloc) {
            __builtin_amdgcn_fence(__ATOMIC_RELEASE, "agent");
            asm volatile("s_waitcnt vmcnt(0)" ::: "memory");
            const unsigned og = xb_add(&bar[XB_TOP], 1u);
            const unsigned tg = og / nx;
            if (og + 1u == (tg + 1u) * nx) xb_add(&bar[XB_TOPGEN], 1u);
            else XB_SPIN(xb_ld(&bar[XB_TOPGEN]) == tg, bar);
            __builtin_amdgcn_fence(__ATOMIC_ACQUIRE, "agent");
            xb_add(&bar[XB_XGEN(b.x)], 1u);
            asm volatile("s_waitcnt vmcnt(0)" ::: "memory");
        } else {
            XB_SPIN(xb_ld(&bar[XB_XGEN(b.x)]) == gen, bar);
            __builtin_amdgcn_fence(__ATOMIC_ACQUIRE, "agent");
            asm volatile("s_waitcnt vmcnt(0)" ::: "memory");
        }
    }
    __syncthreads();
}

namespace pg8 {
constexpr int BM = 256, BK = 64, HALF = 128, HTB = HALF * BK * 2, STAGE_BYTES = 8 * HTB, NXCD = 8, WGM = 8;
__host__ __device__ __forceinline__ int lds_byte(int r, int c) { const int st = (r >> 4) * 2 + (c >> 5), rr = r & 15, cc = c & 31, ob = rr * 64 + cc * 2; return st * 1024 + (ob ^ (((ob >> 9) & 1) << 5)); }
__host__ __device__ __forceinline__ void stage_rc(int b, int& R, int& C) { const int st = b / 1024, sb = b % 1024, swz = sb ^ (((sb >> 9) & 1) << 5); R = (st >> 1) * 16 + swz / 64; C = (st & 1) * 32 + (swz % 64) / 2; }
__host__ __device__ __forceinline__ int perm32(int rho) { const int n = rho >> 4, i = rho & 15; return 8 * (i >> 2) + 4 * n + (i & 3); }
struct Unit { int pm, pn; };
struct Gemm { const bf16_t* A; const bf16_t* Bt; int lda, N, K; };
struct Sched {
    int nM, nN, nwg, G, c, skipctx, extra;
    __device__ void init(int nM_, int N, int G_, int c_, int skip, int extra_ = 0) { nM = nM_; nN = N / BM; nwg = nM * nN; G = G_; c = c_; skipctx = skip; extra = extra_; }
    __device__ bool next(int i, Unit& u) const {
        const long L = (long)i * G + c; if (L >= nwg + extra) return false;
        if (L >= nwg) { const int idx = (int)L - nwg, ci = idx / 5, j = idx - ci * 5; u.pm = ci * 9; u.pn = j < 2 ? 3 + j : (j < 4 ? 4 + j : 10); return true; }
        int wgid = (int)L; { const int q = nwg / NXCD, r = nwg % NXCD, xcd = wgid % NXCD, off = wgid / NXCD; wgid = (xcd < r ? xcd * (q + 1) : r * (q + 1) + (xcd - r) * q) + off; }
        const int nig = WGM * nN, gid = wgid / nig, fm = gid * WGM, gsz = (nM - fm) < WGM ? (nM - fm) : WGM;
        int pm = fm + ((wgid % nig) % gsz); u.pn = (wgid % nig) / gsz;
        if (skipctx) pm = (pm >> 3) * 9 + 1 + (pm & 7);
        u.pm = pm; return true;
    }
};

template <class Epi>
__device__ __forceinline__ void gemm_phase(LAS unsigned char* lds, const Gemm g, const Sched& S, const Epi& E) {
    const int tid = opaque_tid(), wid = __builtin_amdgcn_readfirstlane(tid >> 6), lane = tid & 63, wr = wid >> 2, wc = wid & 3, fr = lane & 15, fq = lane >> 4;
    const int K = g.K, nt = K / BK;
    unsigned voffA[2], voffB[2];
#pragma unroll
    for (int i = 0; i < 2; ++i) { int R, C; stage_rc(tid * 16 + i * 8192, R, C); const int Rb = Epi::PERM ? ((R & ~31) + perm32(R & 31)) : R;
        voffA[i] = (unsigned)(R * g.lda + C) * 2u; voffB[i] = (unsigned)(Rb * K + C) * 2u; }
    const size_t kstep = (size_t)(BK * 2);
    const size_t hstepA = (size_t)HALF * g.lda * 2, hstepB = (size_t)HALF * K * 2;
    const size_t tstepA = 2 * hstepA, tstepB = 2 * hstepB;
    const unsigned ldsw = (unsigned)wid * 1024u;
    const int aoff = lds_byte(wr * 64 + fr, fq * 8), boff = lds_byte(wc * 32 + fr, fq * 8);
#define PG8_SA(b, h) (((b) * 2 + (h)) * HTB)
#define PG8_SB(b, h) ((4 + (b) * 2 + (h)) * HTB)
#define PG8_STAGE(bufoff, gbase, voff) do { _Pragma("unroll") for (int _i = 0; _i < 2; ++_i) \
        __builtin_amdgcn_global_load_lds((const unsigned*)((const char*)(gbase) + (voff)[_i]), (LAS unsigned*)(lds + (bufoff) + ldsw + _i * 8192), 16, 0, 0); } while (0)
#define PG8_LDA(dst, b, h) do { _Pragma("unroll") for (int m = 0; m < 4; ++m) _Pragma("unroll") for (int k = 0; k < 2; ++k) dst[m][k] = *(const LAS bf16x8*)(lds + PG8_SA(b, h) + aoff + m * 2048 + k * 1024); } while (0)
#define PG8_LDB(dst, b, h) do { _Pragma("unroll") for (int n = 0; n < 2; ++n) _Pragma("unroll") for (int k = 0; k < 2; ++k) dst[n][k] = *(const LAS bf16x8*)(lds + PG8_SB(b, h) + boff + n * 2048 + k * 1024); } while (0)
#define PG8_MMA(ai, bj, At, Bt) do { __builtin_amdgcn_s_setprio(1); _Pragma("unroll") for (int m = 0; m < 4; ++m) _Pragma("unroll") for (int n = 0; n < 2; ++n) _Pragma("unroll") for (int k = 0; k < 2; ++k) \
        acc[ai][bj][m][n] = __builtin_amdgcn_mfma_f32_16x16x32_bf16(Bt[n][k], At[m][k], acc[ai][bj][m][n], 0, 0, 0); __builtin_amdgcn_s_setprio(0); } while (0)
#define PG8_WAIT_V(n) asm volatile("s_waitcnt vmcnt(" #n ")" ::: "memory")
#define PG8_WAIT_L(n) asm volatile("s_waitcnt lgkmcnt(" #n ")" ::: "memory")
#define PG8_BAR __builtin_amdgcn_s_barrier()
#define PG8_SCHED __builtin_amdgcn_sched_barrier(0)
    Unit cur, nxt; int ui = 0;
    if (!S.next(0, cur)) return;
    f32x4 acc[2][2][4][2];
#pragma unroll
    for (int a = 0; a < 2; ++a)
#pragma unroll
        for (int b = 0; b < 2; ++b)
#pragma unroll
            for (int m = 0; m < 4; ++m)
#pragma unroll
                for (int n = 0; n < 2; ++n) acc[a][b][m][n] = (f32x4){0.f, 0.f, 0.f, 0.f};
    bf16x8 At[4][2], B0[2][2], B1[2][2];
    const char* cA = (const char*)g.A + (size_t)cur.pm * tstepA; const char* cB = (const char*)g.Bt + (size_t)cur.pn * tstepB;
    PG8_STAGE(PG8_SB(0, 0), cB, voffB); PG8_STAGE(PG8_SA(0, 0), cA, voffA); PG8_STAGE(PG8_SB(0, 1), cB + hstepB, voffB); PG8_STAGE(PG8_SA(0, 1), cA + hstepA, voffA);
    if (wr == 1) PG8_BAR;
    PG8_WAIT_V(4); PG8_BAR;
    PG8_STAGE(PG8_SB(1, 0), cB + kstep, voffB); PG8_STAGE(PG8_SA(1, 0), cA + kstep, voffA); PG8_STAGE(PG8_SB(1, 1), cB + hstepB + kstep, voffB);
    PG8_WAIT_V(6); PG8_BAR;
    for (;;) {
        const bool has_next = S.next(ui + 1, nxt);
        const char* nA = has_next ? (const char*)g.A + (size_t)nxt.pm * tstepA : cA; const char* nB = has_next ? (const char*)g.Bt + (size_t)nxt.pn * tstepB : cB;
        for (int t = 0; t < nt; t += 2) {
            const bool last = (t == nt - 2);
            const char* a1 = cA + (size_t)(t + 1) * kstep;
            const char* a2 = last ? nA : cA + (size_t)(t + 2) * kstep; const char* b2 = last ? nB : cB + (size_t)(t + 2) * kstep;
            const char* a3 = a2 + kstep; const char* b3 = b2 + kstep;
            PG8_LDB(B0, 0, 0); PG8_SCHED; PG8_LDA(At, 0, 0); PG8_STAGE(PG8_SA(1, 1), a1 + hstepA, voffA);
            PG8_WAIT_L(8); PG8_BAR; PG8_WAIT_L(0); PG8_MMA(0, 0, At, B0); PG8_BAR; PG8_SCHED;
            PG8_LDB(B1, 0, 1); PG8_STAGE(PG8_SB(0, 0), b2, voffB);
            PG8_BAR; PG8_WAIT_L(0); PG8_MMA(0, 1, At, B1); PG8_BAR;
            PG8_LDA(At, 0, 1); PG8_STAGE(PG8_SA(0, 0), a2, voffA);
            PG8_BAR; PG8_WAIT_L(0); PG8_MMA(1, 0, At, B0); PG8_BAR; PG8_SCHED;
            PG8_STAGE(PG8_SB(0, 1), b2 + hstepB, voffB);
            PG8_WAIT_V(6); PG8_BAR; PG8_MMA(1, 1, At, B1); PG8_BAR;
            PG8_LDB(B0, 1, 0); PG8_SCHED; PG8_LDA(At, 1, 0); PG8_STAGE(PG8_SA(0, 1), a2 + hstepA, voffA);
            PG8_WAIT_L(8); PG8_BAR; PG8_WAIT_L(0); PG8_MMA(0, 0, At, B0); PG8_BAR; PG8_SCHED;
            PG8_LDB(B1, 1, 1); PG8_STAGE(PG8_SB(1, 0), b3, voffB);
            PG8_BAR; PG8_WAIT_L(0); PG8_MMA(0, 1, At, B1); PG8_BAR;
            PG8_LDA(At, 1, 1); PG8_STAGE(PG8_SA(1, 0), a3, voffA);
            PG8_BAR; PG8_WAIT_L(0); PG8_MMA(1, 0, At, B0); PG8_BAR; PG8_SCHED;
            PG8_STAGE(PG8_SB(1, 1), b3 + hstepB, voffB);
            PG8_WAIT_V(6); PG8_BAR; PG8_MMA(1, 1, At, B1); PG8_BAR;
        }
        E(acc, cur, wr, wc, fr, fq);
        if (!has_next) break;
#pragma unroll
        for (int a = 0; a < 2; ++a)
#pragma unroll
            for (int b = 0; b < 2; ++b)
#pragma unroll
                for (int m = 0; m < 4; ++m)
#pragma unroll
                    for (int n = 0; n < 2; ++n) acc[a][b][m][n] = (f32x4){0.f, 0.f, 0.f, 0.f};
        cur = nxt; cA = nA; cB = nB; ++ui;
    }
    PG8_WAIT_V(0);
    if (wr == 0) PG8_BAR;
    PG8_BAR;
#undef PG8_SA
#undef PG8_SB
#undef PG8_STAGE
#undef PG8_LDA
#undef PG8_LDB
#undef PG8_MMA
#undef PG8_WAIT_V
#undef PG8_WAIT_L
#undef PG8_BAR
#undef PG8_SCHED
}

struct EpiWin {
    static constexpr bool PERM = true;
    bf16_t* PA; bf16_t* PB; const float* gq; const float* gk; bf16_t* HT; unsigned char* lds_tp;
    float* SSQ; float* SSK;
    __device__ __forceinline__ void operator()(const f32x4 (&acc)[2][2][4][2], const Unit& u, int wr, int wc, int fr, int fq) const {
        int oz = 0; asm volatile("" : "+v"(oz));
        const int row0 = u.pm * BM + wr * 64 + fr + oz, pn = u.pn;
        const int sub = u.pm % 9;
        if (pn < 3) {
            bf16_t* patch = (bf16_t*)(lds_tp + (wr * 4 + wc) * 2560);
            bf16_t* OT = HT + (size_t)pn * ((size_t)T * 256);
            const int lane_ = fr + 16 * fq, ch = lane_ >> 1, hf = lane_ & 1;
#pragma unroll
            for (int ai = 0; ai < 2; ++ai)
#pragma unroll
                for (int bj = 0; bj < 2; ++bj)
#pragma unroll
                    for (int mh = 0; mh < 2; ++mh) {
#pragma unroll
                        for (int mm = 0; mm < 2; ++mm) { const int m = mh * 2 + mm;
#pragma unroll
                            for (int n = 0; n < 2; ++n)
#pragma unroll
                                for (int j = 0; j < 4; ++j) patch[(8 * fq + 4 * n + j) * 40 + 16 * mm + fr] = f2bf(acc[ai][bj][m][n][j]); }
                        asm volatile("s_waitcnt lgkmcnt(0)" ::: "memory");
                        const u32x4 w0 = *(const u32x4*)(patch + ch * 40 + 16 * hf), w1 = *(const u32x4*)(patch + ch * 40 + 16 * hf + 8);
                        bf16_t* dst = OT + (size_t)(bj * HALF + wc * 32 + ch) * T + (size_t)u.pm * BM + ai * HALF + wr * 64 + mh * 32 + 16 * hf + oz;
                        *(u32x4*)dst = w0; *(u32x4*)(dst + 8) = w1;
                        asm volatile("s_waitcnt lgkmcnt(0)" ::: "memory"); }
            return;
        }
        const bool headtile = (pn == 5 || pn == 6 || pn == 9 || (pn == 10 && wc < 2));
        if (!headtile) {
            bf16_t* dstb; int ld, cbase, lim;
            if (pn < 3) { dstb = PA; ld = LDPA; cbase = pn * 256; lim = 256; }
            else { dstb = PB; ld = LDPB; lim = 256; cbase = pn == 3 ? C_CQ : (pn == 4 ? C_CKV : (pn == 7 ? C_RV : (pn == 8 ? C_RG : C_GV - 128))); if (pn == 4) lim = 160; }
#pragma unroll
            for (int ai = 0; ai < 2; ++ai)
#pragma unroll
                for (int m = 0; m < 4; ++m) { const size_t row = (size_t)(row0 + ai * HALF + m * 16);
                    if (pn == 3 || pn == 4) {
                        float ss = 0.f;
#pragma unroll
                        for (int n = 0; n < 2; ++n)
#pragma unroll
                            for (int j = 0; j < 4; ++j) { ss += acc[ai][0][m][n][j] * acc[ai][0][m][n][j]; if (pn == 3) ss += acc[ai][1][m][n][j] * acc[ai][1][m][n][j]; }
                        { auto r16 = __builtin_amdgcn_permlane16_swap(__float_as_uint(ss), __float_as_uint(ss), false, false); ss = __uint_as_float(r16[0]) + __uint_as_float(r16[1]);
                          auto r32_ = __builtin_amdgcn_permlane32_swap(__float_as_uint(ss), __float_as_uint(ss), false, false); ss = __uint_as_float(r32_[0]) + __uint_as_float(r32_[1]); }
                        if (fq == 0) (pn == 3 ? SSQ : SSK)[row * 4 + wc] = ss; }
#pragma unroll
                    for (int bj = 0; bj < 2; ++bj) { f32x4 v0 = acc[ai][bj][m][0], v1 = acc[ai][bj][m][1];
                        if (pn == 4 && bj == 1 && wc == 0 && sub != 0) {
                            const float pos = (fq & 1) ? (float)(16 * m + fr) : (float)((sub - 1) * 4 + 2 * ai + wr);
#pragma unroll
                            for (int n = 0; n < 2; ++n)
#pragma unroll
                                for (int j = 0; j < 4; ++j) { const float x = n ? v1[j] : v0[j];
                                    auto rr = __builtin_amdgcn_permlane32_swap(__float_as_uint(x), __float_as_uint(x), false, false);
                                    const float x1 = __uint_as_float(rr[0]), x2 = __uint_as_float(rr[1]);
                                    const float a_ = pos * __builtin_amdgcn_exp2f(-(float)(4 * n + j) * (13.287712379549449f / 8.0f)), cs = __cosf(a_), sn = __sinf(a_);
                                    const float y = (fq < 2) ? x1 * cs - x2 * sn : x2 * cs + x1 * sn;
                                    if (n) v1[j] = y; else v0[j] = y; } }
                        u32x4 w; w.x = cvtpk(v0[0], v0[1]); w.y = cvtpk(v0[2], v0[3]); w.z = cvtpk(v1[0], v1[1]); w.w = cvtpk(v1[2], v1[3]);
                        int cl = bj * HALF + wc * 32 + 8 * fq;
                        if (pn == 10) cl = 128 + (wc - 2) * 64 + bj * 32 + 8 * fq;
                        if (cl < lim) *(u32x4*)(dstb + row * ld + cbase + cl) = w; } }
            return;
        }
        const bool donorm = (pn >= 9); const float kscale = (pn == 6) ? 0.125f : 1.0f;
        const int cbase = (pn == 5 ? C_RQ : (pn == 6 ? C_RK : (pn == 9 ? C_GQ : C_GK))) + 64 * wc + 8 * fq;
        const float* gp = (pn == 9) ? gq : gk;
        f32x4 g4[2][2];
#pragma unroll
        for (int bj = 0; bj < 2; ++bj)
#pragma unroll
            for (int n = 0; n < 2; ++n) g4[bj][n] = donorm ? *(const f32x4*)(gp + 32 * bj + 8 * fq + 4 * n) : (f32x4){1.f, 1.f, 1.f, 1.f};
        float inv[8];
#pragma unroll
        for (int e = 0; e < 8; ++e) inv[e] = exp2f(-(float)((8 * fq + e) & 15) * (13.287712379549449f / 16.0f));
#pragma unroll
        for (int ai = 0; ai < 2; ++ai)
#pragma unroll
            for (int m = 0; m < 4; ++m) { const size_t row = (size_t)(row0 + ai * HALF + m * 16);
                f32x4 x1[2] = {acc[ai][0][m][0], acc[ai][0][m][1]}, x2[2] = {acc[ai][1][m][0], acc[ai][1][m][1]};
                if (donorm) { float ss = 0.f;
#pragma unroll
                    for (int n = 0; n < 2; ++n)
#pragma unroll
                        for (int j = 0; j < 4; ++j) ss += x1[n][j] * x1[n][j] + x2[n][j] * x2[n][j];
                    ss += __shfl_xor(ss, 16); ss += __shfl_xor(ss, 32);
                    const float rstd = rsqrtf(ss * (1.0f / 64.0f) + EPS);
#pragma unroll
                    for (int n = 0; n < 2; ++n) { x1[n] = x1[n] * rstd * g4[0][n]; x2[n] = x2[n] * rstd * g4[1][n]; } }
                const float pos = (fq < 2) ? (float)((sub - 1) * 4 + 2 * ai + wr) : (float)(16 * m + fr);
                unsigned o1[4], o2[4];
#pragma unroll
                for (int n = 0; n < 2; ++n)
#pragma unroll
                    for (int jp = 0; jp < 2; ++jp) { float r1[2], r2[2];
#pragma unroll
                        for (int e = 0; e < 2; ++e) { const int j = 2 * jp + e; float cs = 1.f, sn = 0.f;
                            if (sub != 0) { const float a_ = pos * inv[4 * n + j]; cs = __cosf(a_); sn = __sinf(a_); }
                            const float a1 = x1[n][j] * kscale, a2 = x2[n][j] * kscale;
                            r1[e] = a1 * cs - a2 * sn; r2[e] = a2 * cs + a1 * sn; }
                        o1[2 * n + jp] = cvtpk(r1[0], r1[1]); o2[2 * n + jp] = cvtpk(r2[0], r2[1]); }
                *(u32x4*)(PB + row * LDPB + cbase) = (u32x4){o1[0], o1[1], o1[2], o1[3]};
                *(u32x4*)(PB + row * LDPB + cbase + 32) = (u32x4){o2[0], o2[1], o2[2], o2[3]}; }
    }
};
struct EpiBf {
    static constexpr bool PERM = true;
    bf16_t* O; int ldc; const float* SSQ; const float* SSK;
    __device__ __forceinline__ void operator()(const f32x4 (&acc)[2][2][4][2], const Unit& u, int wr, int wc, int fr, int fq) const {
        int oz = 0; asm volatile("" : "+v"(oz));
        const int row0 = u.pm * BM + wr * 64 + fr + oz, col0 = u.pn * BM + wc * 32 + 8 * fq;
        int cls[2];
#pragma unroll
        for (int bj = 0; bj < 2; ++bj) { const int n = col0 + bj * HALF; cls[bj] = n < 384 ? 0 : (n < 768 ? ((n - 384) % 96 < 64 ? 1 : 2) : 1); }
        float rq[8], rk[8];
        { u32x4 t[8];
#pragma unroll
          for (int i = 0; i < 8; ++i) t[i] = *(const u32x4*)(SSQ + (size_t)(row0 + (i >> 2) * HALF + (i & 3) * 16) * 4);
#pragma unroll
          for (int i = 0; i < 8; ++i) rq[i] = rsqrtf((__uint_as_float(t[i].x) + __uint_as_float(t[i].y) + __uint_as_float(t[i].z) + __uint_as_float(t[i].w)) * (1.0f / 256.0f) + EPS);
#pragma unroll
          for (int i = 0; i < 8; ++i) t[i] = *(const u32x4*)(SSK + (size_t)(row0 + (i >> 2) * HALF + (i & 3) * 16) * 4);
#pragma unroll
          for (int i = 0; i < 8; ++i) rk[i] = rsqrtf((__uint_as_float(t[i].x) + __uint_as_float(t[i].y) + __uint_as_float(t[i].z) + __uint_as_float(t[i].w)) * (1.0f / 128.0f) + EPS); }
#pragma unroll
        for (int ai = 0; ai < 2; ++ai)
#pragma unroll
            for (int m = 0; m < 4; ++m) { bf16_t* rowp = O + (size_t)(row0 + ai * HALF + m * 16) * ldc + col0;
#pragma unroll
                for (int bj = 0; bj < 2; ++bj) { const float sc = cls[bj] == 0 ? rq[ai * 4 + m] : (cls[bj] == 1 ? rk[ai * 4 + m] : 1.0f);
                    const f32x4 v0 = acc[ai][bj][m][0] * sc, v1 = acc[ai][bj][m][1] * sc;
                    u32x4 w; w.x = cvtpk(v0[0], v0[1]); w.y = cvtpk(v0[2], v0[3]); w.z = cvtpk(v1[0], v1[1]); w.w = cvtpk(v1[2], v1[3]);
                    *(u32x4*)(rowp + bj * HALF) = w; } }
    }
};
struct EpiSwiglu {
    static constexpr bool PERM = true;
    bf16_t* H;
    __device__ __forceinline__ void operator()(const f32x4 (&acc)[2][2][4][2], const Unit& u, int wr, int wc, int fr, int fq) const {
        const int row0 = u.pm * BM + wr * 64 + fr, col0 = u.pn * 128 + wc * 32 + 8 * fq;
#pragma unroll
        for (int ai = 0; ai < 2; ++ai)
#pragma unroll
            for (int m = 0; m < 4; ++m) { bf16_t* rowp = H + (size_t)(row0 + ai * HALF + m * 16) * DFF + col0;
                float hv[8];
#pragma unroll
                for (int n = 0; n < 2; ++n)
#pragma unroll
                    for (int j = 0; j < 4; ++j) { const float a = acc[ai][0][m][n][j], gg = acc[ai][1][m][n][j]; hv[n * 4 + j] = a * __builtin_amdgcn_rcpf(1.0f + __expf(-a)) * gg; }
                u32x4 w; w.x = cvtpk(hv[0], hv[1]); w.y = cvtpk(hv[2], hv[3]); w.z = cvtpk(hv[4], hv[5]); w.w = cvtpk(hv[6], hv[7]);
                *(u32x4*)rowp = w; }
    }
};
struct EpiRes {
    static constexpr bool PERM = true;
    const float* x_in; const float* ctx_in; bf16_t* XS; const float* gate; int from_inputs;
    __device__ __forceinline__ void operator()(const f32x4 (&acc)[2][2][4][2], const Unit& u, int wr, int wc, int fr, int fq) const {
        const int b = u.pm / 9, sub = u.pm - b * 9;
        const float* basef = sub == 0 ? ctx_in + (size_t)b * 256 * 1024 : x_in + ((size_t)b * 2048 + (size_t)(sub - 1) * 256) * 1024;
        bf16_t* outp = XS + (size_t)u.pm * 256 * 1024;
        const float* gp = gate + (size_t)(sub == 0 ? 32 : b) * 6144;
        int oz = 0; asm volatile("" : "+v"(oz));
        const int rl0 = wr * 64 + fr + oz, col0 = u.pn * BM + wc * 32 + 8 * fq + oz;
        f32x4 gv[2][2];
#pragma unroll
        for (int bj = 0; bj < 2; ++bj)
#pragma unroll
            for (int n = 0; n < 2; ++n) gv[bj][n] = *(const f32x4*)(gp + col0 + bj * HALF + n * 4);
        if (from_inputs) {
#pragma unroll
          for (int ai = 0; ai < 2; ++ai)
#pragma unroll
            for (int mp = 0; mp < 2; ++mp) {
              f32x4 bs[2][2][2];
#pragma unroll
              for (int mm = 0; mm < 2; ++mm) { const size_t off = (size_t)(rl0 + ai * HALF + (mp * 2 + mm) * 16) * 1024 + col0;
#pragma unroll
                for (int bj = 0; bj < 2; ++bj)
#pragma unroll
                    for (int n = 0; n < 2; ++n) bs[mm][bj][n] = *(const f32x4*)(basef + off + bj * HALF + n * 4); }
#pragma unroll
              for (int mm = 0; mm < 2; ++mm) { const size_t off = (size_t)(rl0 + ai * HALF + (mp * 2 + mm) * 16) * 1024 + col0;
#pragma unroll
                for (int bj = 0; bj < 2; ++bj) { const f32x4 v0 = bs[mm][bj][0] + gv[bj][0] * acc[ai][bj][mp * 2 + mm][0], v1 = bs[mm][bj][1] + gv[bj][1] * acc[ai][bj][mp * 2 + mm][1];
                    u32x4 w; w.x = cvtpk(v0[0], v0[1]); w.y = cvtpk(v0[2], v0[3]); w.z = cvtpk(v1[0], v1[1]); w.w = cvtpk(v1[2], v1[3]); *(u32x4*)(outp + off + bj * HALF) = w; } }
              asm volatile("" ::: "memory"); }
        } else {
#pragma unroll
          for (int ai = 0; ai < 2; ++ai) {
              u32x4 bs[4][2];
#pragma unroll
              for (int m = 0; m < 4; ++m) { const size_t off = (size_t)(rl0 + ai * HALF + m * 16) * 1024 + col0;
#pragma unroll
                for (int bj = 0; bj < 2; ++bj) bs[m][bj] = *(const u32x4*)(outp + off + bj * HALF); }
#pragma unroll
              for (int m = 0; m < 4; ++m) { const size_t off = (size_t)(rl0 + ai * HALF + m * 16) * 1024 + col0;
#pragma unroll
                for (int bj = 0; bj < 2; ++bj) { const u32x4 bw = bs[m][bj];
                    const f32x4 b0 = {lo16(bw.x), hi16(bw.x), lo16(bw.y), hi16(bw.y)}, b1 = {lo16(bw.z), hi16(bw.z), lo16(bw.w), hi16(bw.w)};
                    const f32x4 v0 = b0 + gv[bj][0] * acc[ai][bj][m][0], v1 = b1 + gv[bj][1] * acc[ai][bj][m][1];
                    u32x4 w; w.x = cvtpk(v0[0], v0[1]); w.y = cvtpk(v0[2], v0[3]); w.z = cvtpk(v1[0], v1[1]); w.w = cvtpk(v1[2], v1[3]); *(u32x4*)(outp + off + bj * HALF) = w; } }
              asm volatile("" ::: "memory"); }
        }
    }
};
}

namespace att {
constexpr int KVBLK = 64;
constexpr size_t SHM_V = 64 * 64 * 2, SHM_K = 64 * 128 * 2;
#define KSWZ(row, colB) ((row) * 256 + ((colB) ^ (((row) & 7) << 4)))
#define SBAR() __builtin_amdgcn_sched_barrier(0)
__device__ __forceinline__ int crow(int r, int hi) { return (r & 3) + 8 * (r >> 2) + 4 * hi; }
__device__ __forceinline__ void partialSM(f32x16& p0, f32x16& p1, float& m_reg, float& mn, float& alpha, float C, float thr) {
  float pmax = p0[0];
#pragma unroll
  for (int r = 1; r < 16; ++r) pmax = fmaxf(pmax, p0[r]);
#pragma unroll
  for (int r = 0; r < 16; ++r) pmax = fmaxf(pmax, p1[r]);
  { auto rr = __builtin_amdgcn_permlane32_swap(__float_as_uint(pmax), __float_as_uint(pmax), false, false);
    pmax = fmaxf(__uint_as_float(rr[0]), __uint_as_float(rr[1])); }
  if (__builtin_expect(__all(pmax - m_reg <= thr), 1)) { mn = m_reg; alpha = 1.f; }
  else { mn = fmaxf(m_reg, pmax); alpha = __builtin_amdgcn_exp2f((m_reg - mn) * C); m_reg = mn; }
  float mnC = -mn * C;
#pragma unroll
  for (int r = 0; r < 16; ++r) p0[r] = fmaf(p0[r], C, mnC);
#pragma unroll
  for (int r = 0; r < 16; ++r) p1[r] = fmaf(p1[r], C, mnC);
#pragma unroll
  for (int r = 0; r < 16; ++r) p0[r] = __builtin_amdgcn_exp2f(p0[r]);
}
#define PK4(P, BASE, OUT) do { unsigned a0 = cvtpk(P[BASE + 0], P[BASE + 1]), a1 = cvtpk(P[BASE + 2], P[BASE + 3]);   \
    unsigned b0 = cvtpk(P[BASE + 4], P[BASE + 5]), b1 = cvtpk(P[BASE + 6], P[BASE + 7]);                              \
    auto r0 = __builtin_amdgcn_permlane32_swap(a0, b0, false, false); auto r1 = __builtin_amdgcn_permlane32_swap(a1, b1, false, false); \
    u32x4 w = {r0[0], r1[0], r0[1], r1[1]}; OUT = *reinterpret_cast<bf16x8*>(&w); } while (0)
__device__ __forceinline__ void finishSM(f32x16& p0, f32x16& p1, float alpha, float& l_reg, bf16x8& pa0, bf16x8& pa1, bf16x8& pa2, bf16x8& pa3) {
#pragma unroll
  for (int r = 0; r < 16; ++r) p1[r] = __builtin_amdgcn_exp2f(p1[r]);
  float ps = 0;
#pragma unroll
  for (int r = 0; r < 16; ++r) ps += p0[r];
#pragma unroll
  for (int r = 0; r < 16; ++r) ps += p1[r];
  { auto rr = __builtin_amdgcn_permlane32_swap(__float_as_uint(ps), __float_as_uint(ps), false, false);
    ps = __uint_as_float(rr[0]) + __uint_as_float(rr[1]); }
  l_reg = l_reg * alpha + ps;
  PK4(p0, 0, pa0); PK4(p0, 8, pa1); PK4(p1, 0, pa2); PK4(p1, 8, pa3);
}
__device__ __forceinline__ void finishRET(f32x16& p0, f32x16& p1, int n, int key0, int hi, float lgf, float lgb, int pre, int Lr, bf16x8& pa0, bf16x8& pa1, bf16x8& pa2, bf16x8& pa3) {
  if (key0 < pre) {
#pragma unroll
    for (int r = 0; r < 16; ++r) { const int k0 = key0 + crow(r, hi), k1 = k0 + 32;
      p0[r] *= __builtin_amdgcn_exp2f(lgf * (float)(n + pre - k0)) + __builtin_amdgcn_exp2f(lgb * (float)(Lr + k0 - n));
      p1[r] *= __builtin_amdgcn_exp2f(lgf * (float)(n + pre - k1)) + __builtin_amdgcn_exp2f(lgb * (float)(Lr + k1 - n)); }
  } else {
#pragma unroll
    for (int r = 0; r < 16; ++r) { const int d0 = n + pre - (key0 + crow(r, hi)), d1 = d0 - 32;
      const float f0 = (float)d0, f1 = (float)d1;
      float w0 = __builtin_amdgcn_exp2f(d0 > 0 ? lgf * f0 : -lgb * f0); if (d0 == 0) w0 = 2.f;
      float w1 = __builtin_amdgcn_exp2f(d1 > 0 ? lgf * f1 : -lgb * f1); if (d1 == 0) w1 = 2.f;
      p0[r] *= w0; p1[r] *= w1; }
  }
  PK4(p0, 0, pa0); PK4(p0, 8, pa1); PK4(p1, 0, pa2); PK4(p1, 8, pa3);
}
template <int ND>
__device__ __forceinline__ void qkt(f32x16& p0, f32x16& p1, const bf16_t* Ks, const bf16x8* qr, int r32, int hi) {
  p0 = f32x16{}; p1 = f32x16{};
#pragma unroll
  for (int d0 = 0; d0 < ND; ++d0) { int cb = (d0 * 16 + hi * 8) * 2;
    bf16x8 b0 = *reinterpret_cast<const bf16x8*>((const char*)Ks + KSWZ(r32, cb));
    bf16x8 b1 = *reinterpret_cast<const bf16x8*>((const char*)Ks + KSWZ(32 + r32, cb));
    p0 = __builtin_amdgcn_mfma_f32_32x32x16_bf16(b0, qr[d0], p0, 0, 0, 0);
    p1 = __builtin_amdgcn_mfma_f32_32x32x16_bf16(b1, qr[d0], p1, 0, 0, 0); }
}
__device__ __forceinline__ int v_st(int k, int c) { const int kk = (k & ~0xC) | ((k & 4) << 1) | ((k & 8) >> 1); return ((kk >> 3) * 2 + (c >> 5)) * 512 + ((kk & 7) * 32 + (c & 31)) * 2; }
__device__ __forceinline__ int v_rd_base(int lane) { return ((lane & 3) << 3) | (((lane >> 2) & 3) << 6) | (((lane >> 4) & 1) << 5) | (((lane >> 5) & 1) << 8); }
constexpr int v_rd_off(int d0, int ks, int half) { return d0 * 512 + ks * 2048 + half * 1024; }
template <int OFF> __device__ __forceinline__ s16x4 tr_read(int vb) {
  s16x4 r; asm volatile("ds_read_b64_tr_b16 %0, %1 offset:%2" : "=&v"(r) : "v"(vb), "i"(OFF) : "memory"); return r;
}
template <int D0> __device__ __forceinline__ void pv_one(f32x16& od, int vb, bf16x8 pa0, bf16x8 pa1, bf16x8 pa2, bf16x8 pa3) {
  const s16x4 l0 = tr_read<v_rd_off(D0, 0, 0)>(vb), h0 = tr_read<v_rd_off(D0, 0, 1)>(vb), l1 = tr_read<v_rd_off(D0, 1, 0)>(vb), h1 = tr_read<v_rd_off(D0, 1, 1)>(vb);
  const s16x4 l2 = tr_read<v_rd_off(D0, 2, 0)>(vb), h2 = tr_read<v_rd_off(D0, 2, 1)>(vb), l3 = tr_read<v_rd_off(D0, 3, 0)>(vb), h3 = tr_read<v_rd_off(D0, 3, 1)>(vb);
  asm volatile("s_waitcnt lgkmcnt(0)" ::: "memory"); SBAR();
#define PKV(L, H) (bf16x8){L[0], L[1], L[2], L[3], H[0], H[1], H[2], H[3]}
  od = __builtin_amdgcn_mfma_f32_32x32x16_bf16(pa0, PKV(l0, h0), od, 0, 0, 0);
  od = __builtin_amdgcn_mfma_f32_32x32x16_bf16(pa1, PKV(l1, h1), od, 0, 0, 0);
  od = __builtin_amdgcn_mfma_f32_32x32x16_bf16(pa2, PKV(l2, h2), od, 0, 0, 0);
  od = __builtin_amdgcn_mfma_f32_32x32x16_bf16(pa3, PKV(l3, h3), od, 0, 0, 0);
#undef PKV
}
__device__ __forceinline__ void pv_d0(f32x16* o, int vb, bf16x8 pa0, bf16x8 pa1, bf16x8 pa2, bf16x8 pa3) {
  pv_one<0>(o[0], vb, pa0, pa1, pa2, pa3); pv_one<1>(o[1], vb, pa0, pa1, pa2, pa3);
}

template <int DK, int MODE, bool ROPEQ>
__device__ __forceinline__ void attn_body(const bf16_t* Qb, int ldq, const bf16_t* Kh, const bf16_t* Vh, int ldk, bf16_t* Ob, int ldo, int seq, char* lds,
                                          float C, float thr, int qpos0, float lgf, float lgb, int pre, int Lr, const bf16_t* Sf = nullptr, const bf16_t* Sb = nullptr) {
  constexpr int ND = DK / 16;
  const int tid = opaque_tid(), wid = tid >> 6, lane = tid & 63, r32 = lane & 31, hi = lane >> 5;
  bf16_t* V_lds = (bf16_t*)lds; bf16_t* K_lds = (bf16_t*)(lds + 2 * SHM_V);
  float* wsp = (float*)(lds + 2 * SHM_V + 2 * SHM_K) + wid * 64; float* li_l = wsp; float* al_l = wsp + 32;
  float m_reg = -1e30f, l_reg = 0; f32x16 o[2] = {}; bf16x8 qr[ND];
  const bf16_t* Qw = Qb + (long)(wid * 32 + r32) * ldq + hi * 8;
#pragma unroll
  for (int d0 = 0; d0 < ND; ++d0) qr[d0] = *reinterpret_cast<const bf16x8*>(Qw + d0 * 16);
  const int sr = tid >> 4, sc = (tid & 15) * 8;
  const int vk = tid >> 3, vc = (tid & 7) * 8, vst0 = v_st(vk, vc);
  const int vb0 = (int)(uintptr_t)V_lds + v_rd_base(lane);
  struct { bf16x8 vs0, ks0, ks1; } sr_[2];
#define SLOAD(i, k0) do { sr_[i].vs0 = *reinterpret_cast<const bf16x8*>(&Vh[(long)((k0) + vk) * ldk + vc]); \
    sr_[i].ks0 = *reinterpret_cast<const bf16x8*>(&Kh[(long)((k0) + sr) * ldk + sc]); sr_[i].ks1 = *reinterpret_cast<const bf16x8*>(&Kh[(long)((k0) + 32 + sr) * ldk + sc]); } while (0)
  SLOAD(0, 0); SLOAD(1, KVBLK);
  const int npos = qpos0 + wid * 32 + r32;
  if constexpr (ROPEQ) {
    const float pos = hi ? (float)(npos & 63) : (float)(npos >> 6);
    u32x4 w1 = *reinterpret_cast<u32x4*>(&qr[4]), w2 = *reinterpret_cast<u32x4*>(&qr[5]);
    unsigned a1[4] = {w1.x, w1.y, w1.z, w1.w}, a2[4] = {w2.x, w2.y, w2.z, w2.w};
#pragma unroll
    for (int jj = 0; jj < 4; ++jj) {
      float x1l = lo16(a1[jj]), x1h = hi16(a1[jj]), x2l = lo16(a2[jj]), x2h = hi16(a2[jj]);
      float sl, cl, sh, ch;
      { const float a0_ = pos * exp2f(-(float)(2 * jj) * (13.287712379549449f / 8.0f)), a1_ = pos * exp2f(-(float)(2 * jj + 1) * (13.287712379549449f / 8.0f));
        sl = __sinf(a0_); cl = __cosf(a0_); sh = __sinf(a1_); ch = __cosf(a1_); }
      a1[jj] = cvtpk(x1l * cl - x2l * sl, x1h * ch - x2h * sh);
      a2[jj] = cvtpk(x2l * cl + x1l * sl, x2h * ch + x1h * sh);
    }
    w1 = (u32x4){a1[0], a1[1], a1[2], a1[3]}; w2 = (u32x4){a2[0], a2[1], a2[2], a2[3]};
    qr[4] = *reinterpret_cast<bf16x8*>(&w1); qr[5] = *reinterpret_cast<bf16x8*>(&w2);
  }
#define SWRITE(b, i) do { *(bf16x8*)((char*)V_lds + (b) * SHM_V + vst0) = sr_[i].vs0; int kc = sc * 2;               \
    *(bf16x8*)((char*)K_lds + (b) * SHM_K + KSWZ(sr, kc)) = sr_[i].ks0;                       \
    *(bf16x8*)((char*)K_lds + (b) * SHM_K + KSWZ(32 + sr, kc)) = sr_[i].ks1; } while (0)
#define SWAIT() asm volatile("s_waitcnt vmcnt(3)" ::: "memory")
#define RESC(a) do { if (MODE == 0) { if (__any((a) < 1.f)) { if (hi == 0) al_l[r32] = (a); asm volatile("s_waitcnt lgkmcnt(0)" ::: "memory"); \
    _Pragma("unroll") for (int d = 0; d < 2; ++d) _Pragma("unroll") for (int r = 0; r < 16; ++r) o[d][r] *= al_l[crow(r, hi)]; } } } while (0)
#define PSM(P0, P1, MN, AL) do { if (MODE == 0) partialSM(P0, P1, m_reg, MN, AL, C, thr); } while (0)
#define FSM(P0, P1, AL, KEY0) do { if (MODE == 0) finishSM(P0, P1, AL, l_reg, pa0, pa1, pa2, pa3); else finishRET(P0, P1, npos, KEY0, hi, lgf, lgb, pre, Lr, pa0, pa1, pa2, pa3); } while (0)
  f32x16 pA0, pA1, pB0, pB1; float mnA = 0, mnB = 0, alA = 1.f, alB = 1.f; bf16x8 pa0, pa1, pa2, pa3; const int NT = seq / KVBLK;
  constexpr int SE = 0, SO = 1;
  asm volatile("s_waitcnt vmcnt(3)" ::: "memory"); SWRITE(0, SE); __syncthreads();
  if (2 < NT) SLOAD(SE, 2 * KVBLK);
  qkt<ND>(pA0, pA1, K_lds, qr, r32, hi); PSM(pA0, pA1, mnA, alA);
  SWAIT(); SWRITE(1, SO); __syncthreads();
  for (int j = 1; j + 1 < NT; j += 2) {
    SBAR(); qkt<ND>(pB0, pB1, (bf16_t*)((char*)K_lds + SHM_K), qr, r32, hi);
    FSM(pA0, pA1, alA, (j - 1) * KVBLK); SBAR();
    SLOAD(SO, (j + 2) * KVBLK); SBAR();
    pv_d0(o, vb0, pa0, pa1, pa2, pa3); PSM(pB0, pB1, mnB, alB);
    __syncthreads(); SWAIT(); SWRITE(0, SE);
    RESC(alB); __syncthreads();
    SBAR(); qkt<ND>(pA0, pA1, K_lds, qr, r32, hi);
    FSM(pB0, pB1, alB, j * KVBLK); SBAR();
    if (j + 3 < NT) SLOAD(SE, (j + 3) * KVBLK); SBAR();
    pv_d0(o, vb0 + (int)SHM_V, pa0, pa1, pa2, pa3); PSM(pA0, pA1, mnA, alA);
    __syncthreads(); SWAIT(); SWRITE(1, SO);
    RESC(alA); __syncthreads();
  }
  SBAR(); qkt<ND>(pB0, pB1, (bf16_t*)((char*)K_lds + SHM_K), qr, r32, hi);
  FSM(pA0, pA1, alA, (NT - 2) * KVBLK); SBAR();
  pv_d0(o, vb0, pa0, pa1, pa2, pa3); PSM(pB0, pB1, mnB, alB);
  __syncthreads(); RESC(alB);
  FSM(pB0, pB1, alB, (NT - 1) * KVBLK); SBAR();
  pv_d0(o, vb0 + (int)SHM_V, pa0, pa1, pa2, pa3);
  if constexpr (MODE == 1) {
    if (Sf != nullptr) {
      __syncthreads();
      *(bf16x8*)((char*)V_lds + vst0) = *reinterpret_cast<const bf16x8*>(Sf + vk * 64 + vc);
      *(bf16x8*)((char*)V_lds + SHM_V + vst0) = *reinterpret_cast<const bf16x8*>(Sb + vk * 64 + vc);
      __syncthreads();
      const float wf = __builtin_amdgcn_exp2f(lgf * (float)(npos + 1)), wb = __builtin_amdgcn_exp2f(lgb * (float)(256 - npos));
#pragma unroll
      for (int dir = 0; dir < 2; ++dir) { const float w = dir ? wb : wf; bf16x8 pq[4];
#pragma unroll
        for (int i = 0; i < 4; ++i) { const u32x4 qw = *reinterpret_cast<const u32x4*>(&qr[i]);
          u32x4 r; r.x = cvtpk(lo16(qw.x) * w, hi16(qw.x) * w); r.y = cvtpk(lo16(qw.y) * w, hi16(qw.y) * w); r.z = cvtpk(lo16(qw.z) * w, hi16(qw.z) * w); r.w = cvtpk(lo16(qw.w) * w, hi16(qw.w) * w);
          pq[i] = *reinterpret_cast<bf16x8*>(&r); }
        pv_d0(o, vb0 + dir * (int)SHM_V, pq[0], pq[1], pq[2], pq[3]); }
    }
  }
  float rli[16];
  if (MODE == 0) {
    if (hi == 0) li_l[r32] = l_reg; asm volatile("s_waitcnt lgkmcnt(0)" ::: "memory");
#pragma unroll
    for (int r = 0; r < 16; ++r) rli[r] = __builtin_amdgcn_rcpf(li_l[crow(r, hi)]);
  } else {
#pragma unroll
    for (int r = 0; r < 16; ++r) rli[r] = 1.f;
  }
  bf16_t* Ow = Ob + (long)(wid * 32) * ldo;
#pragma unroll
  for (int r = 0; r < 16; ++r) { int orow = crow(r, hi);
#pragma unroll
    for (int d0 = 0; d0 < 2; ++d0) Ow[(long)orow * ldo + d0 * 32 + r32] = f2bf(o[d0][r] * rli[r]); }
  __syncthreads();
#undef SLOAD
#undef SWRITE
#undef SWAIT
#undef RESC
#undef PSM
#undef FSM
}
}

__device__ __forceinline__ void tr_tile(const float* W, int ldw, int k0, int srcn0, int nvalid, bf16_t* dst, int ldk, float* tile, int srcn1 = -1) {
  const int tid = opaque_tid();
  if (srcn1 < 0) srcn1 = srcn0 + 32;
#pragma unroll
  for (int i = 0; i < 8; ++i) { const int kk = i * 8 + (tid >> 6), nn = tid & 63; tile[nn * 65 + kk] = nn < nvalid ? W[(size_t)(k0 + kk) * ldw + (nn < 32 ? srcn0 + nn : srcn1 + nn - 32)] : 0.f; }
  __syncthreads();
#pragma unroll
  for (int i = 0; i < 8; ++i) { const int nn = i * 8 + (tid >> 6), kk = tid & 63; dst[(size_t)nn * ldk + kk] = f2bf(tile[nn * 65 + kk]); }
  __syncthreads();
}

__device__ __forceinline__ void phase0(const Params& p, unsigned char* shm) {
  unsigned char* ws = p.ws; const int tid = opaque_tid(), wid = tid >> 6, lane = tid & 63;
  float* fl = (float*)shm;
  for (int it = (int)gridDim.x - 1 - (int)blockIdx.x; it < 192; it += gridDim.x) {
    const int l = it / 96, cg0 = (it % 96) * 64, col = tid & 63, g = tid >> 6;
    const float* wm = p.in[4] + (size_t)l * 1024 * 6144;
    float acc[33];
#pragma unroll
    for (int r = 0; r < 33; ++r) acc[r] = 0.f;
    for (int half = 0; half < 2; ++half) {
      __syncthreads();
      for (int e = tid; e < 33 * 512; e += 512) { const int r = e >> 9, kk = e & 511; const float cv = r < 32 ? p.in[1][r * 1024 + half * 512 + kk] : p.in[3][half * 512 + kk];
        fl[r * 512 + kk] = cv / (1.0f + expf(-cv)); }
      __syncthreads();
      for (int kk = 0; kk < 64; ++kk) { const int kl = g * 64 + kk; const float w = wm[(size_t)(half * 512 + kl) * 6144 + cg0 + col];
#pragma unroll
        for (int r = 0; r < 33; ++r) acc[r] += fl[r * 512 + kl] * w; }
    }
    __syncthreads();
#pragma unroll
    for (int r = 0; r < 33; ++r) fl[(g * 33 + r) * 64 + col] = acc[r];
    __syncthreads();
    for (int e = tid; e < 33 * 64; e += 512) { const int r = e >> 6, cc = e & 63; float s = p.in[5][l * 6144 + cg0 + cc];
#pragma unroll
      for (int gg = 0; gg < 8; ++gg) s += fl[(gg * 33 + r) * 64 + cc];
      ((float*)(ws + WS_MOD))[(size_t)(l * 33 + r) * 6144 + cg0 + cc] = s; }
    __syncthreads();
  }
  for (int it = blockIdx.x; it < 144; it += gridDim.x) {
    const int l = it / 72, r_ = it % 72, which = r_ >= 64, pg = which ? r_ - 64 : r_, L = which ? 256 : 2048;
    float* zs = fl + wid * 64; float* hs = fl + 512 + wid * 256; float* nsum = fl + 512 + 2048;
    const float frq = p.in[17][l * 64 + lane];
    for (int j = 0; j < 4; ++j) {
      const int n = pg * 32 + wid * 4 + j;
      const float tt = (float)n / (float)(L - 1), wpos = 6.283185307179586f * (float)n / (float)L;
      __syncthreads();
      { float z = 0.f;
        if (lane == 0) z = tt;
        else if (lane < 17) { const float fb = 1e-4f + (float)(lane - 1) * ((15.0f - 1e-4f) / 15.0f); z = cosf(fb * wpos); }
        else if (lane < 33) { const float fb = 1e-4f + (float)(lane - 17) * ((15.0f - 1e-4f) / 15.0f); z = -sinf(fb * wpos); }
        zs[lane] = z; }
      __syncthreads();
      float h1;
      { const float* w1 = p.in[11] + l * 33 * 64; float a = p.in[12][l * 64 + lane];
#pragma unroll
        for (int i = 0; i < 33; ++i) a += zs[i] * w1[i * 64 + lane];
        h1 = sinf(frq * a); }
      __syncthreads(); zs[lane] = h1; __syncthreads();
      float h2;
      { const float* w2 = p.in[13] + l * 64 * 64; float a = p.in[14][l * 64 + lane];
#pragma unroll 16
        for (int i = 0; i < 64; ++i) a += zs[i] * w2[i * 64 + lane];
        h2 = sinf(frq * a); }
      __syncthreads(); zs[lane] = h2; __syncthreads();
      { const float* w3 = p.in[15] + l * 64 * 64; float a = p.in[16][l * 64 + lane];
#pragma unroll 16
        for (int i = 0; i < 64; ++i) a += zs[i] * w3[i * 64 + lane];
        hs[j * 64 + lane] = sinf(frq * a); }
    }
    __syncthreads();
    { const float* w4 = p.in[18] + (size_t)l * 64 * 1024; float a[4][16];
#pragma unroll
      for (int j = 0; j < 4; ++j)
#pragma unroll
        for (int m = 0; m < 16; ++m) a[j][m] = 0.f;
#pragma unroll 2
      for (int k = 0; k < 64; ++k) { float wv[16];
#pragma unroll
        for (int m = 0; m < 16; ++m) wv[m] = w4[k * 1024 + m * 64 + lane];
#pragma unroll
        for (int j = 0; j < 4; ++j) { const float hv = hs[j * 64 + k];
#pragma unroll
          for (int m = 0; m < 16; ++m) a[j][m] += hv * wv[m]; } }
      bf16_t* krev = which ? (bf16_t*)(ws + WS_KREVC) + (size_t)l * 512 * 512 : (bf16_t*)(ws + WS_KREVL) + (size_t)l * 512 * 4096;
#pragma unroll
      for (int m = 0; m < 16; ++m) { const int f = m * 64 + lane, o = f >> 9, dir = (f >> 8) & 1, c = f & 255;
        const float delta = -15.350567286626973f + (float)f * ((-3.0701134573253945f + 15.350567286626973f) / 1023.0f);
        float sabs = 0.f;
#pragma unroll
        for (int j = 0; j < 4; ++j) { const int n = pg * 32 + wid * 4 + j; const float tt = (float)n / (float)(L - 1);
          float v = a[j][m] * (expf(-tt * fabsf(delta)) + 0.05f);
          int x = dir ? L + n : L - n;
          if (dir && n == 0) { x = 0; v = 0.f; }
          krev[(size_t)(o * 256 + c) * (2 * L) + x] = f2bf(v); sabs += fabsf(v); }
        nsum[wid * 1024 + f] = sabs; } }
    __syncthreads();
    for (int f = tid; f < 1024; f += 512) { float sm = 0.f;
#pragma unroll
      for (int w = 0; w < 8; ++w) sm += nsum[w * 1024 + f];
      atomicAdd((float*)(ws + WS_NORM) + (l * 2 + which) * 512 + (f >> 9) * 256 + (f & 255), sm); }
    __syncthreads();
  }
  for (int it = blockIdx.x; it < 6144; it += gridDim.x) {
    if (it < 1408) { const int l = it / 704, r = it % 704, nt = r / 16, kt = r % 16; const int n0 = nt * 64, tl = n0 >> 8, t0 = n0 & 255;
      int s0 = 0, s1 = -1, nv = 64; const int bj = t0 >> 7, wa = (t0 & 127) >> 5;
      if (tl < 3) s0 = n0;
      else if (tl == 3) s0 = 768 + t0;
      else if (tl == 4) { s0 = 1024 + t0; nv = t0 < 128 ? 64 : (t0 == 128 ? 32 : 0); if (nv == 0) s0 = 0; }
      else if (tl == 5 || tl == 6 || tl == 9) { const int base = tl == 5 ? 1184 : (tl == 6 ? 1440 : 2208); s0 = base + 64 * wa + 32 * bj; s1 = base + 64 * (wa + 1) + 32 * bj; }
      else if (tl == 7) s0 = 1696 + t0;
      else if (tl == 8) s0 = 1952 + t0;
      else { const int base = wa == 0 ? 2464 : 2592; s0 = base + 32 * bj; s1 = base + 64 + 32 * bj; }
      tr_tile(p.in[8] + (size_t)l * 1024 * INC, INC, kt * 64, s0, nv, (bf16_t*)(ws + WS_WIN) + ((size_t)l * 2816 + n0) * 1024 + kt * 64, 1024, fl, s1); }
    else if (it < 1920) { const int r0 = it - 1408, l = r0 / 256, r = r0 % 256, nt = r / 16, kt = r % 16;
      tr_tile(p.in[29] + (size_t)l * 1024 * 1024, 1024, kt * 64, nt * 64, 64, (bf16_t*)(ws + WS_WOUT) + ((size_t)l * 1024 + nt * 64) * 1024 + kt * 64, 1024, fl); }
    else if (it < 4736) { const int r0 = it - 1920, l = r0 / 1408, r = r0 % 1408, nt = r / 16, kt = r % 16; const int n0 = nt * 64, pn = n0 >> 8, cl = n0 & 255;
      const int src = cl < 128 ? pn * 128 + cl : DFF + pn * 128 + cl - 128;
      tr_tile(p.in[30] + (size_t)l * 1024 * 5632, 5632, kt * 64, src, 64, (bf16_t*)(ws + WS_WFI) + ((size_t)l * 5632 + n0) * 1024 + kt * 64, 1024, fl); }
    else { const int r0 = it - 4736, l = r0 / 704, r = r0 % 704, nt = r / 44, kt = r % 44;
      tr_tile(p.in[31] + (size_t)l * DFF * 1024, 1024, kt * 64, nt * 64, 64, (bf16_t*)(ws + WS_WFO) + ((size_t)l * 1024 + nt * 64) * DFF + kt * 64, DFF, fl); }
  }
  for (size_t e = (size_t)blockIdx.x * 512 + tid; e < (size_t)2 * 1024 * 512; e += (size_t)gridDim.x * 512) {
    const int l = (int)(e >> 19), n = (int)((e >> 9) & 1023), k = (int)(e & 511); float v = 0.f;
    const float* wuq = p.in[21] + (size_t)l * 256 * 384; const float* wukv = p.in[23] + (size_t)l * 128 * 512;
    const float gk_ = k < 256 ? p.in[20][l * 256 + k] : (k < 384 ? p.in[22][l * 128 + k - 256] : 1.0f);
    if (n < 384) { if (k < 256) v = wuq[k * 384 + n] * gk_; }
    else if (n < 768) { const int nn = n - 384, h = nn / 96, d = nn % 96;
      if (d < 64) { if (k >= 256 && k < 384) v = wukv[(k - 256) * 512 + h * 128 + d] * gk_; } else if (k == 384 + d - 64) v = 1.0f; }
    else { const int nn = n - 768, h = nn >> 6, ee = nn & 63; if (k >= 256 && k < 384) v = wukv[(k - 256) * 512 + h * 128 + 64 + ee] * gk_; }
    ((bf16_t*)(ws + WS_WUP))[e] = f2bf(v);
  }
}

__device__ __forceinline__ void norm_phase(const Params& p, int l, int which, bool from_inputs, bool skipctx) {
  const int tid_ = opaque_tid(), wid = tid_ >> 6, lane = tid_ & 63;
  const float* gv = p.in[which ? 7 : 6] + l * 1024;
  const bf16_t* XS = (const bf16_t*)(p.ws + WS_XS); bf16_t* XA = (bf16_t*)(p.ws + WS_XA); const float* MOD = (const float*)(p.ws + WS_MOD);
  for (int r0 = (blockIdx.x * 8 + wid) * 4; r0 < T; r0 += gridDim.x * 32) {
    const int b = r0 / RPB, i0 = r0 - b * RPB;
    if (skipctx && i0 < NCTX) continue;
    const float* md = MOD + ((size_t)(l * 33 + (i0 < NCTX ? 32 : b)) * 6 + which * 3) * 1024;
    if (from_inputs) {
      const float* src = i0 < NCTX ? p.in[2] + ((size_t)b * 256 + i0) * 1024 : p.in[0] + ((size_t)b * 2048 + (i0 - 256)) * 1024;
      f32x4 v[4][4];
#pragma unroll
      for (int u = 0; u < 4; ++u)
#pragma unroll
        for (int q = 0; q < 4; ++q) v[u][q] = *(const f32x4*)(src + (size_t)u * 1024 + q * 256 + lane * 4);
      f32x4 g4[4], sh[4];
#pragma unroll
      for (int q = 0; q < 4; ++q) { const int col = q * 256 + lane * 4; g4[q] = *(const f32x4*)(gv + col); sh[q] = *(const f32x4*)(md + col); const f32x4 sc = *(const f32x4*)(md + 1024 + col);
        g4[q] = g4[q] * (sc + 1.0f); }
#pragma unroll
      for (int u = 0; u < 4; ++u) { float ss = 0.f;
#pragma unroll
        for (int q = 0; q < 4; ++q) ss += v[u][q][0] * v[u][q][0] + v[u][q][1] * v[u][q][1] + v[u][q][2] * v[u][q][2] + v[u][q][3] * v[u][q][3];
        ss = wsum(ss); const float rstd = rsqrtf(ss * (1.0f / 1024.0f) + EPS);
#pragma unroll
        for (int q = 0; q < 4; ++q) { const int col = q * 256 + lane * 4; const f32x4 y = v[u][q] * rstd * g4[q] + sh[q];
          u32x2 w; w.x = cvtpk(y[0], y[1]); w.y = cvtpk(y[2], y[3]); *(u32x2*)(XA + (size_t)(r0 + u) * 1024 + col) = w; } }
    } else {
      u32x4 v[4][2];
#pragma unroll
      for (int u = 0; u < 4; ++u)
#pragma unroll
        for (int q = 0; q < 2; ++q) v[u][q] = *(const u32x4*)(XS + (size_t)(r0 + u) * 1024 + q * 512 + lane * 8);
      f32x4 g4[2][2], sh[2][2];
#pragma unroll
      for (int q = 0; q < 2; ++q)
#pragma unroll
        for (int hf = 0; hf < 2; ++hf) { const int col = q * 512 + lane * 8 + hf * 4; g4[q][hf] = *(const f32x4*)(gv + col); sh[q][hf] = *(const f32x4*)(md + col); const f32x4 sc = *(const f32x4*)(md + 1024 + col);
          g4[q][hf] = g4[q][hf] * (sc + 1.0f); }
#pragma unroll
      for (int u = 0; u < 4; ++u) { f32x4 x[2][2]; float ss = 0.f;
#pragma unroll
        for (int q = 0; q < 2; ++q) { x[q][0] = (f32x4){lo16(v[u][q].x), hi16(v[u][q].x), lo16(v[u][q].y), hi16(v[u][q].y)}; x[q][1] = (f32x4){lo16(v[u][q].z), hi16(v[u][q].z), lo16(v[u][q].w), hi16(v[u][q].w)};
#pragma unroll
          for (int hf = 0; hf < 2; ++hf) ss += x[q][hf][0] * x[q][hf][0] + x[q][hf][1] * x[q][hf][1] + x[q][hf][2] * x[q][hf][2] + x[q][hf][3] * x[q][hf][3]; }
        ss = wsum(ss); const float rstd = rsqrtf(ss * (1.0f / 1024.0f) + EPS);
#pragma unroll
        for (int q = 0; q < 2; ++q) { const f32x4 y0 = x[q][0] * rstd * g4[q][0] + sh[q][0], y1 = x[q][1] * rstd * g4[q][1] + sh[q][1];
          u32x4 w; w.x = cvtpk(y0[0], y0[1]); w.y = cvtpk(y0[2], y0[3]); w.z = cvtpk(y1[0], y1[1]); w.w = cvtpk(y1[2], y1[3]);
          *(u32x4*)(XA + (size_t)(r0 + u) * 1024 + q * 512 + lane * 8) = w; } }
    }
  }
}

__device__ __forceinline__ void rope2(bf16_t* q, float c0, float s0, float c1, float s1, float scale) {
  const unsigned w1 = *(const unsigned*)q, w2 = *(const unsigned*)(q + 32);
  const float x1a = lo16(w1) * scale, x1b = hi16(w1) * scale, x2a = lo16(w2) * scale, x2b = hi16(w2) * scale;
  *(unsigned*)q = cvtpk(x1a * c0 - x2a * s0, x1b * c1 - x2b * s1);
  *(unsigned*)(q + 32) = cvtpk(x2a * c0 + x1a * s0, x2b * c1 + x1b * s1);
}
__device__ __forceinline__ void normrope(bf16_t* q, const float* g, float c0, float s0, float c1, float s1) {
  const unsigned w1 = *(const unsigned*)q, w2 = *(const unsigned*)(q + 32);
  float x1a = lo16(w1), x1b = hi16(w1), x2a = lo16(w2), x2b = hi16(w2);
  const float ss = gsum16(x1a * x1a + x1b * x1b + x2a * x2a + x2b * x2b), rstd = rsqrtf(ss * (1.0f / 64.0f) + EPS);
  x1a *= rstd * g[0]; x1b *= rstd * g[1]; x2a *= rstd * g[32]; x2b *= rstd * g[33];
  *(unsigned*)q = cvtpk(x1a * c0 - x2a * s0, x1b * c1 - x2b * s1);
  *(unsigned*)(q + 32) = cvtpk(x2a * c0 + x1a * s0, x2b * c1 + x1b * s1);
}
__device__ __forceinline__ void prep_phase(const Params& p, int l, unsigned char* shm) {
  const int tid = opaque_tid(), wid = tid >> 6, lane = tid & 63;
  bf16_t* PB = (bf16_t*)(p.ws + WS_PB); const bf16_t* PA = (const bf16_t*)(p.ws + WS_PA);
  const float* gq_mla = p.in[20] + l * 256; const float* gkv = p.in[22] + l * 128;
  const float LT = 13.287712379549449f;
  const float inv8 = exp2f(-(float)(lane & 7) * (LT / 8.0f));
  const f32x4 g4 = *(const f32x4*)(gq_mla + 4 * lane); const float gkv0 = gkv[2 * lane], gkv1 = gkv[2 * lane + 1];
  for (int r0 = (blockIdx.x * 8 + wid) * 4; r0 < T; r0 += gridDim.x * 32) {
    u32x2 cqw[4]; unsigned ckw[4]; bf16_t kr1[4], kr2[4];
#pragma unroll
    for (int u = 0; u < 4; ++u) { const bf16_t* row = PB + (size_t)(r0 + u) * LDPB;
      cqw[u] = *(const u32x2*)(row + C_CQ + 4 * lane); ckw[u] = *(const unsigned*)(row + C_CKV + 2 * lane);
      kr1[u] = row[C_KR + (lane & 15)]; kr2[u] = row[C_KR + 16 + (lane & 15)]; }
#pragma unroll
    for (int u = 0; u < 4; ++u) { const int r = r0 + u; const int b = r / RPB, i = r - b * RPB; const bool lat = i >= NCTX; const int t = i - NCTX;
      const float prow = (float)(t >> 6), pcol = (float)(t & 63);
      bf16_t* row = PB + (size_t)r * LDPB;
      { float x0 = lo16(cqw[u].x), x1 = hi16(cqw[u].x), x2 = lo16(cqw[u].y), x3 = hi16(cqw[u].y);
        const float ss = wsum(x0 * x0 + x1 * x1 + x2 * x2 + x3 * x3), rstd = rsqrtf(ss * (1.0f / 256.0f) + EPS);
        u32x2 w; w.x = cvtpk(x0 * rstd * g4[0], x1 * rstd * g4[1]); w.y = cvtpk(x2 * rstd * g4[2], x3 * rstd * g4[3]); *(u32x2*)(row + C_CQ + 4 * lane) = w; }
      { float x0 = lo16(ckw[u]), x1 = hi16(ckw[u]);
        const float ss = wsum(x0 * x0 + x1 * x1), rstd = rsqrtf(ss * (1.0f / 128.0f) + EPS);
        *(unsigned*)(row + C_CKV + 2 * lane) = cvtpk(x0 * rstd * gkv0, x1 * rstd * gkv1); }
      if (lat && lane < 16) { const float a_ = (lane < 8 ? prow : pcol) * inv8; const float sn = __sinf(a_), cs = __cosf(a_);
        const float x1 = bf2f(kr1[u]), x2 = bf2f(kr2[u]);
        row[C_KR + lane] = f2bf(x1 * cs - x2 * sn); row[C_KR + 16 + lane] = f2bf(x2 * cs + x1 * sn); }
    }
  }
}

constexpr int HY_CS = 5152;
constexpr int HY_UOFF = 8 * HY_CS, HY_RS = 528;
__device__ __forceinline__ void conv16(const bf16_t* P, size_t a, int t0, int L, float w0, float w1, float w2, float bb, float (&y)[16]) {
  const u32x4 q0 = *(const u32x4*)(P + a), q1 = *(const u32x4*)(P + a + 8);
  float r[18];
  r[0] = t0 > 0 ? bf2f(P[a - 1]) : 0.f; r[17] = (t0 + 16 < L) ? bf2f(P[a + 16]) : 0.f;
  r[1] = lo16(q0.x); r[2] = hi16(q0.x); r[3] = lo16(q0.y); r[4] = hi16(q0.y); r[5] = lo16(q0.z); r[6] = hi16(q0.z); r[7] = lo16(q0.w); r[8] = hi16(q0.w);
  r[9] = lo16(q1.x); r[10] = hi16(q1.x); r[11] = lo16(q1.y); r[12] = hi16(q1.y); r[13] = lo16(q1.z); r[14] = hi16(q1.z); r[15] = lo16(q1.w); r[16] = hi16(q1.w);
#pragma unroll
  for (int e = 0; e < 16; ++e) y[e] = w0 * r[e] + w1 * r[e + 1] + w2 * r[e + 2] + bb;
}
template <int TB, bool UCONV>
__device__ __forceinline__ void hy_conv_item(unsigned char* shm, const bf16_t* UT, const bf16_t* XT, bf16_t* OUT, const bf16_t* krev, int L, int off, int tb0, float invnorm, float dskip, int c,
                                             float uw0, float uw1, float uw2, float ub, float xw0_, float xw1_, float xw2_, float xb_) {
  constexpr int RBW = TB / 256;
  const int tid = opaque_tid(), wid = tid >> 6, lane = tid & 63, r32 = lane & 31, hi = lane >> 5;
  bf16_t* G = (bf16_t*)shm; unsigned char* U = shm + HY_UOFF;
  const int glen = TB + L;
  __syncthreads();
  if (tid < glen / 8) { const int y0 = tid * 8, xb = L - tb0 - TB + y0;
    u32x4 cA = (u32x4){0u, 0u, 0u, 0u}, cB = (u32x4){0u, 0u, 0u, 0u};
    if (y0 >= 8 && xb - 8 >= 0 && xb - 8 < 2 * L) cA = *(const u32x4*)(krev + xb - 8);
    if (xb >= 0 && xb < 2 * L) cB = *(const u32x4*)(krev + xb);
    const unsigned C8[8] = {cA.x, cA.y, cA.z, cA.w, cB.x, cB.y, cB.z, cB.w};
#pragma unroll
    for (int a = 0; a < 8; ++a) { unsigned o4[4];
#pragma unroll
      for (int w = 0; w < 4; ++w) { const int e0 = 8 + 2 * w - a;
        if ((a & 1) == 0) o4[w] = C8[e0 >> 1];
        else o4[w] = __builtin_amdgcn_alignbit(C8[(e0 + 1) >> 1], C8[(e0 - 1) >> 1], 16); }
      *(u32x4*)((unsigned char*)G + a * HY_CS + y0 * 2) = (u32x4){o4[0], o4[1], o4[2], o4[3]}; } }
  const bf16_t* Uc = UT + (size_t)c * T + off;
  f32x16 acc[RBW];
#pragma unroll
  for (int i = 0; i < RBW; ++i) acc[i] = f32x16{};
  const int nch = L / 256;
  bf16x8 st[2]; bf16_t pvs[2] = {0, 0}, nxs[2] = {0, 0};
#pragma unroll
  for (int i = 0; i < 2; ++i) { const int q = tid + 512 * i, bb = q >> 5, s8 = (q & 31) * 8; st[i] = *(const bf16x8*)(Uc + (size_t)bb * RPB + s8);
    if (UCONV) { pvs[i] = s8 > 0 ? Uc[(size_t)bb * RPB + s8 - 1] : (bf16_t)0; nxs[i] = (s8 + 8 < L) ? Uc[(size_t)bb * RPB + s8 + 8] : (bf16_t)0; } }
  for (int ch = 0; ch < nch; ++ch) {
    __syncthreads();
#pragma unroll
    for (int i = 0; i < 2; ++i) { const int q = tid + 512 * i, bb = q >> 5, s8 = (q & 31) * 8;
      if (UCONV) { const u32x4 qw = *reinterpret_cast<const u32x4*>(&st[i]);
        const float r[10] = {bf2f(pvs[i]), lo16(qw.x), hi16(qw.x), lo16(qw.y), hi16(qw.y), lo16(qw.z), hi16(qw.z), lo16(qw.w), hi16(qw.w), bf2f(nxs[i])};
        float y[8];
#pragma unroll
        for (int e = 0; e < 8; ++e) y[e] = uw0 * r[e] + uw1 * r[e + 1] + uw2 * r[e + 2] + ub;
        *(u32x4*)(U + bb * HY_RS + s8 * 2) = (u32x4){cvtpk(y[0], y[1]), cvtpk(y[2], y[3]), cvtpk(y[4], y[5]), cvtpk(y[6], y[7])}; }
      else *(bf16x8*)(U + bb * HY_RS + s8 * 2) = st[i]; }
    __syncthreads();
    if (ch + 1 < nch) {
#pragma unroll
      for (int i = 0; i < 2; ++i) { const int q = tid + 512 * i, bb = q >> 5, s8 = (q & 31) * 8, sg = (ch + 1) * 256 + s8; st[i] = *(const bf16x8*)(Uc + (size_t)bb * RPB + sg);
        if (UCONV) { pvs[i] = Uc[(size_t)bb * RPB + sg - 1]; nxs[i] = (sg + 8 < L) ? Uc[(size_t)bb * RPB + sg + 8] : (bf16_t)0; } } }
#pragma unroll 4
    for (int ks = 0; ks < 16; ++ks) {
      const int sl = ks * 16 + 8 * hi;
      const bf16x8 bfrag = *(const bf16x8*)(U + r32 * HY_RS + sl * 2);
#pragma unroll
      for (int i = 0; i < RBW; ++i) { const int rb = wid * RBW + i; const int y0 = TB - rb * 32 - (r32 & ~7) + ch * 256 + sl;
        const bf16x8 afrag = *(const bf16x8*)((const unsigned char*)G + (r32 & 7) * HY_CS + y0 * 2);
        acc[i] = __builtin_amdgcn_mfma_f32_32x32x16_bf16(afrag, bfrag, acc[i], 0, 0, 0); }
    }
  }
  float* patch = (float*)(shm + 65536) + wid * (32 * 33);
  const int eb = lane >> 1, eh = (lane & 1) * 16;
#pragma unroll
  for (int i = 0; i < RBW; ++i) { const int rb = wid * RBW + i;
#pragma unroll
    for (int r = 0; r < 16; ++r) patch[att::crow(r, hi) * 33 + r32] = acc[i][r];
    asm volatile("s_waitcnt lgkmcnt(0)" ::: "memory");
    const size_t a = (size_t)c * T + (size_t)eb * RPB + off + tb0 + rb * 32 + eh;
    const int t0e = tb0 + rb * 32 + eh;
    float xv[16], uv[16];
    conv16(XT, a, t0e, L, xw0_, xw1_, xw2_, xb_, xv);
    if (UCONV) conv16(UT, a, t0e, L, uw0, uw1, uw2, ub, uv);
    else { const u32x4 u0 = *(const u32x4*)(UT + a), u1 = *(const u32x4*)(UT + a + 8);
      uv[0] = lo16(u0.x); uv[1] = hi16(u0.x); uv[2] = lo16(u0.y); uv[3] = hi16(u0.y); uv[4] = lo16(u0.z); uv[5] = hi16(u0.z); uv[6] = lo16(u0.w); uv[7] = hi16(u0.w);
      uv[8] = lo16(u1.x); uv[9] = hi16(u1.x); uv[10] = lo16(u1.y); uv[11] = hi16(u1.y); uv[12] = lo16(u1.z); uv[13] = hi16(u1.z); uv[14] = lo16(u1.w); uv[15] = hi16(u1.w); }
    float cv[16];
#pragma unroll
    for (int e = 0; e < 16; ++e) cv[e] = patch[(eh + e) * 33 + eb];
    unsigned ow[8];
#pragma unroll
    for (int e = 0; e < 8; ++e) ow[e] = cvtpk(xv[2 * e] * (cv[2 * e] * invnorm + uv[2 * e] * dskip), xv[2 * e + 1] * (cv[2 * e + 1] * invnorm + uv[2 * e + 1] * dskip));
    *(u32x4*)(OUT + a) = (u32x4){ow[0], ow[1], ow[2], ow[3]}; *(u32x4*)(OUT + a + 8) = (u32x4){ow[4], ow[5], ow[6], ow[7]};
    asm volatile("s_waitcnt lgkmcnt(0)" ::: "memory");
  }
}
__device__ __forceinline__ void hy_order_items(const Params& p, int l, int order, int it, unsigned char* shm) {
  const bf16_t* UT = (const bf16_t*)(p.ws + (order == 0 ? WS_VT : WS_ZZT)); const bf16_t* XT = (const bf16_t*)(p.ws + (order == 0 ? WS_X1T : WS_X2T));
  bf16_t* OUT = (bf16_t*)(p.ws + (order == 0 ? WS_ZZT : WS_YAT));
  const float* NORM = (const float*)(p.ws + WS_NORM);
  const bool lat = it < 1024; const int c = lat ? it >> 2 : it - 1024, tb = it & 3;
  const float* cw = p.in[9] + l * 3 * 768; const float* cb = p.in[10] + l * 768; const int xs = (order == 0 ? 256 : 512) + c;
  const float u0 = cw[c], u1 = cw[768 + c], u2 = cw[1536 + c], ub = cb[c], x0 = cw[xs], x1 = cw[768 + xs], x2 = cw[1536 + xs], xb = cb[xs];
  const float dsk = p.in[19][l * 512 + order * 256 + c];
  if (lat) { const bf16_t* krev = (const bf16_t*)(p.ws + WS_KREVL) + ((size_t)l * 512 + order * 256 + c) * 4096; const float inn = 1.0f / NORM[(l * 2 + 0) * 512 + order * 256 + c];
    if (order == 0) hy_conv_item<512, true>(shm, UT, XT, OUT, krev, 2048, 256, tb * 512, inn, dsk, c, u0, u1, u2, ub, x0, x1, x2, xb);
    else hy_conv_item<512, false>(shm, UT, XT, OUT, krev, 2048, 256, tb * 512, inn, dsk, c, u0, u1, u2, ub, x0, x1, x2, xb); }
  else { const bf16_t* krev = (const bf16_t*)(p.ws + WS_KREVC) + ((size_t)l * 512 + order * 256 + c) * 512; const float inn = 1.0f / NORM[(l * 2 + 1) * 512 + order * 256 + c];
    if (order == 0) hy_conv_item<256, true>(shm, UT, XT, OUT, krev, 256, 0, 0, inn, dsk, c, u0, u1, u2, ub, x0, x1, x2, xb);
    else hy_conv_item<256, false>(shm, UT, XT, OUT, krev, 256, 0, 0, inn, dsk, c, u0, u1, u2, ub, x0, x1, x2, xb); }
}


__device__ __forceinline__ float log2_sigmoid(float x) { return -log1pf(expf(-x)) * 1.4426950408889634f; }
__device__ __forceinline__ void ret_state_item(const Params& p, int l, int it, unsigned char* shm) {
  const int tid = opaque_tid(), wid = tid >> 6, lane = tid & 63, r32 = lane & 31, hi = lane >> 5;
  const int b = it >> 3, h = (it >> 1) & 3, dir = it & 1;
  const bf16_t* PB = (const bf16_t*)(p.ws + WS_PB);
  const bf16_t* Kh = PB + (size_t)b * RPB * LDPB + C_RK + h * 64; const bf16_t* Vh = PB + (size_t)b * RPB * LDPB + C_RV + h * 64;
  bf16_t* ST = (bf16_t*)(p.ws + WS_RST) + (size_t)((b * 4 + h) * 2 + dir) * 8 * 4096;
  const float lg = log2_sigmoid(p.in[24][l * 8 + dir * 4 + h]);
  const int vk = tid >> 3, vc = (tid & 7) * 8, vst0 = att::v_st(vk, vc);
  char* K_l = (char*)shm; char* V_l = (char*)shm + 8192;
  const int kb = (int)(uintptr_t)K_l + att::v_rd_base(lane), vb = (int)(uintptr_t)V_l + att::v_rd_base(lane);
  const float wk = __builtin_amdgcn_exp2f(lg * (float)(dir ? vk : 63 - vk)), dec64 = __builtin_amdgcn_exp2f(lg * 64.0f);
  const int db = (wid >> 1) & 1, eb = wid & 1;
  f32x16 acc = f32x16{};
  auto rowtile = [&](int s) { return dir ? (s < 4 ? 3 - s : 39 - s) : s; };
  bf16x8 kreg, vreg;
  { const int rt = rowtile(0); kreg = *reinterpret_cast<const bf16x8*>(Kh + (size_t)(rt * 64 + vk) * LDPB + vc); vreg = *reinterpret_cast<const bf16x8*>(Vh + (size_t)(rt * 64 + vk) * LDPB + vc); }
  const int nsteps = dir ? 32 : 32;
  for (int s_ = 0; s_ < nsteps; ++s_) {
    __syncthreads();
    { const u32x4 kw = *reinterpret_cast<const u32x4*>(&kreg); u32x4 r;
      r.x = cvtpk(lo16(kw.x) * wk, hi16(kw.x) * wk); r.y = cvtpk(lo16(kw.y) * wk, hi16(kw.y) * wk); r.z = cvtpk(lo16(kw.z) * wk, hi16(kw.z) * wk); r.w = cvtpk(lo16(kw.w) * wk, hi16(kw.w) * wk);
      *(u32x4*)(K_l + vst0) = r; *(bf16x8*)(V_l + vst0) = vreg; }
    __syncthreads();
    if (s_ + 1 < nsteps) { const int rt = rowtile(s_ + 1); kreg = *reinterpret_cast<const bf16x8*>(Kh + (size_t)(rt * 64 + vk) * LDPB + vc); vreg = *reinterpret_cast<const bf16x8*>(Vh + (size_t)(rt * 64 + vk) * LDPB + vc); }
    if (wid < 4) {
#pragma unroll
      for (int r = 0; r < 16; ++r) acc[r] *= dec64;
#define PKV2(L, H) (bf16x8){L[0], L[1], L[2], L[3], H[0], H[1], H[2], H[3]}
#define ST_STEP(KS) do { const s16x4 al = db ? att::tr_read<att::v_rd_off(1, KS, 0)>(kb) : att::tr_read<att::v_rd_off(0, KS, 0)>(kb), ah = db ? att::tr_read<att::v_rd_off(1, KS, 1)>(kb) : att::tr_read<att::v_rd_off(0, KS, 1)>(kb); \
        const s16x4 bl = eb ? att::tr_read<att::v_rd_off(1, KS, 0)>(vb) : att::tr_read<att::v_rd_off(0, KS, 0)>(vb), bh = eb ? att::tr_read<att::v_rd_off(1, KS, 1)>(vb) : att::tr_read<att::v_rd_off(0, KS, 1)>(vb); \
        asm volatile("s_waitcnt lgkmcnt(0)" ::: "memory"); __builtin_amdgcn_sched_barrier(0); \
        acc = __builtin_amdgcn_mfma_f32_32x32x16_bf16(PKV2(al, ah), PKV2(bl, bh), acc, 0, 0, 0); } while (0)
      ST_STEP(0); ST_STEP(1); ST_STEP(2); ST_STEP(3);
#undef ST_STEP
#undef PKV2
      int qb = -1;
      if (!dir) { if (((s_ + 1) & 3) == 0) qb = (s_ + 1) / 4 - 1; }
      else { if (s_ == 3) qb = 7; else if (s_ > 3) { const int rt = 39 - s_; if (((rt - 4) & 3) == 0 && rt >= 8) qb = (rt - 4) / 4 - 1; } }
      if (qb >= 0 && qb < 8) { bf16_t* dst = ST + (size_t)qb * 4096;
#pragma unroll
        for (int r = 0; r < 16; ++r) dst[(att::crow(r, hi) + 32 * db) * 64 + 32 * eb + r32] = f2bf(acc[r]); }
    }
  }
  __syncthreads();
}

__device__ __forceinline__ void attn_item(const Params& p, int l, int kind, int it, unsigned char* shm) {
  bf16_t* PB = (bf16_t*)(p.ws + WS_PB); bf16_t* UM = (bf16_t*)(p.ws + WS_XA);
  const bool lat = it < 1024; int b, h, qb;
  if (lat) { const int k_ = it >> 8, x_ = it & 7, slot = (it & 255) >> 3; b = k_ * 8 + x_; h = slot >> 3; qb = slot & 7; }
  else { const int j = it - 1024; b = j >> 2; h = j & 3; qb = 0; }
  const size_t krow0 = (size_t)b * RPB, qrow0 = krow0 + (lat ? 256 + qb * 256 : 0);
  const int seq = lat ? RPB : NCTX;
  const float L2E = 1.4426950408889634f;
  if (kind == 0) {
    bf16_t* Q = PB + qrow0 * LDPB + C_GQ + h * 64; const bf16_t* K = PB + krow0 * LDPB + C_GK + (h >> 1) * 64; const bf16_t* V = PB + krow0 * LDPB + C_GV + (h >> 1) * 64;
    att::attn_body<64, 0, false>(Q, LDPB, K, V, LDPB, Q, LDPB, seq, (char*)shm, 0.125f * L2E, 8.0f / 0.125f, qb * 256, 0.f, 0.f, 0, 0);
  } else if (kind == 1) {
    bf16_t* Q = PB + qrow0 * LDPB + C_RQ + h * 64; const bf16_t* K = PB + qrow0 * LDPB + C_RK + h * 64; const bf16_t* V = PB + qrow0 * LDPB + C_RV + h * 64;
    const float lgf = log2_sigmoid(p.in[24][l * 8 + h]), lgb = log2_sigmoid(p.in[24][l * 8 + 4 + h]);
    const bf16_t* ST = (const bf16_t*)(p.ws + WS_RST) + (size_t)(b * 4 + h) * 2 * 8 * 4096;
    att::attn_body<64, 1, false>(Q, LDPB, K, V, LDPB, Q, LDPB, 256, (char*)shm, 1.f, 0.f, 0, lgf, lgb, 0, 256, lat ? ST + (size_t)qb * 4096 : nullptr, lat ? ST + (size_t)(8 + qb) * 4096 : nullptr);
  } else {
    bf16_t* Q = UM + qrow0 * LDU + h * 96; const bf16_t* K = UM + krow0 * LDU + 384 + h * 96; const bf16_t* V = UM + krow0 * LDU + 768 + h * 64;
    const float sc = 0.10206207261596577f;
    if (lat) att::attn_body<96, 0, true>(Q, LDU, K, V, LDU, Q, LDU, seq, (char*)shm, sc * L2E, 8.0f / sc, qb * 256, 0.f, 0.f, 0, 0);
    else att::attn_body<96, 0, false>(Q, LDU, K, V, LDU, Q, LDU, seq, (char*)shm, sc * L2E, 8.0f / sc, 0, 0.f, 0.f, 0, 0);
  }
}

__device__ __forceinline__ void merge_phase(const Params& p, int l, bool with_ctx, unsigned char* shm) {
  const int tid = opaque_tid(), wid = tid >> 6, lane = tid & 63;
  const bf16_t* PB = (const bf16_t*)(p.ws + WS_PB); const bf16_t* YAT = (const bf16_t*)(p.ws + WS_YAT); bf16_t* XA = (bf16_t*)(p.ws + WS_XA);
  const float* go = p.in[28] + l * 1024; const float* grn = p.in[25] + l * 256;
  bf16_t* tileT = (bf16_t*)shm;
  for (int tile = blockIdx.x; tile < T / 64; tile += gridDim.x) {
    const int r0 = tile * 64, i0 = r0 % RPB;
    if (!with_ctx && i0 < NCTX) continue;
    __syncthreads();
#pragma unroll
    for (int i = 0; i < 4; ++i) { const int q = tid + 512 * i, c = q >> 3, rc = (q & 7) * 8; const bf16x8 v = *(const bf16x8*)(YAT + (size_t)c * T + r0 + rc);
#pragma unroll
      for (int e = 0; e < 8; ++e) tileT[(rc + e) * 264 + c] = (bf16_t)v[e]; }
    __syncthreads();
    const f32x4 g0 = *(const f32x4*)(go + 4 * lane), g1 = *(const f32x4*)(go + 256 + 4 * lane), g2 = *(const f32x4*)(go + 512 + 4 * lane), g3 = *(const f32x4*)(go + 768 + 4 * lane);
    const f32x4 grn4 = *(const f32x4*)(grn + 4 * lane);
#pragma unroll 1
    for (int half = 0; half < 2; ++half) {
      u32x2 wa[4], wb[4], wc[4], wg[4], wd[4];
#pragma unroll
      for (int u = 0; u < 4; ++u) { const int rl = wid * 8 + half * 4 + u; const size_t r = (size_t)r0 + rl;
        wa[u] = *(const u32x2*)(tileT + rl * 264 + 4 * lane);
        wb[u] = *(const u32x2*)(XA + r * LDU + (lane >> 4) * 96 + (lane & 15) * 4);
        wc[u] = *(const u32x2*)(PB + r * LDPB + C_RQ + 4 * lane); wg[u] = *(const u32x2*)(PB + r * LDPB + C_RG + 4 * lane);
        wd[u] = *(const u32x2*)(PB + r * LDPB + C_GQ + 4 * lane); }
#pragma unroll
      for (int u = 0; u < 4; ++u) { const int rl = wid * 8 + half * 4 + u; const size_t r = (size_t)r0 + rl;
        float ya[4] = {lo16(wa[u].x), hi16(wa[u].x), lo16(wa[u].y), hi16(wa[u].y)}, yb[4] = {lo16(wb[u].x), hi16(wb[u].x), lo16(wb[u].y), hi16(wb[u].y)};
        float yc[4] = {lo16(wc[u].x), hi16(wc[u].x), lo16(wc[u].y), hi16(wc[u].y)}, yd[4] = {lo16(wd[u].x), hi16(wd[u].x), lo16(wd[u].y), hi16(wd[u].y)};
        const float gg[4] = {lo16(wg[u].x), hi16(wg[u].x), lo16(wg[u].y), hi16(wg[u].y)};
        { const float ss = gsum16(yc[0] * yc[0] + yc[1] * yc[1] + yc[2] * yc[2] + yc[3] * yc[3]), rstd = rsqrtf(ss * (1.0f / 64.0f) + EPS);
#pragma unroll
          for (int j = 0; j < 4; ++j) yc[j] = yc[j] * rstd * grn4[j] * (gg[j] * __builtin_amdgcn_rcpf(1.0f + __expf(-gg[j]))); }
        float sa = ya[0] * ya[0] + ya[1] * ya[1] + ya[2] * ya[2] + ya[3] * ya[3], sb = yb[0] * yb[0] + yb[1] * yb[1] + yb[2] * yb[2] + yb[3] * yb[3];
        float sc = yc[0] * yc[0] + yc[1] * yc[1] + yc[2] * yc[2] + yc[3] * yc[3], sd = yd[0] * yd[0] + yd[1] * yd[1] + yd[2] * yd[2] + yd[3] * yd[3];
        sa = wsum(sa); sb = wsum(sb); sc = wsum(sc); sd = wsum(sd);
        const float ra = rsqrtf(sa * (1.0f / 256.0f) + EPS), rb = rsqrtf(sb * (1.0f / 256.0f) + EPS), rc_ = rsqrtf(sc * (1.0f / 256.0f) + EPS), rd = rsqrtf(sd * (1.0f / 256.0f) + EPS);
        u32x2 w; bf16_t* orow = XA + r * 1024 + 4 * lane;
        w.x = cvtpk(ya[0] * ra * g0[0], ya[1] * ra * g0[1]); w.y = cvtpk(ya[2] * ra * g0[2], ya[3] * ra * g0[3]); *(u32x2*)(orow) = w;
        w.x = cvtpk(yb[0] * rb * g1[0], yb[1] * rb * g1[1]); w.y = cvtpk(yb[2] * rb * g1[2], yb[3] * rb * g1[3]); *(u32x2*)(orow + 256) = w;
        w.x = cvtpk(yc[0] * rc_ * g2[0], yc[1] * rc_ * g2[1]); w.y = cvtpk(yc[2] * rc_ * g2[2], yc[3] * rc_ * g2[3]); *(u32x2*)(orow + 512) = w;
        w.x = cvtpk(yd[0] * rd * g3[0], yd[1] * rd * g3[1]); w.y = cvtpk(yd[2] * rd * g3[2], yd[3] * rd * g3[3]); *(u32x2*)(orow + 768) = w; }
    }
  }
}

__device__ __forceinline__ void final_phase(const Params& p) {
  const int tid_ = opaque_tid(), wid = tid_ >> 6, lane = tid_ & 63;
  const bf16_t* XS = (const bf16_t*)(p.ws + WS_XS); const float* gv = p.in[32];
  f32x4 g4[2][2];
#pragma unroll
  for (int q = 0; q < 2; ++q)
#pragma unroll
    for (int hf = 0; hf < 2; ++hf) g4[q][hf] = *(const f32x4*)(gv + q * 512 + lane * 8 + hf * 4);
  for (int q0 = (blockIdx.x * 8 + wid) * 4; q0 < NB * SEQ; q0 += gridDim.x * 32) {
    const int b = q0 >> 11, t = q0 & 2047; const bf16_t* src = XS + ((size_t)b * RPB + 256 + t) * 1024; float* dst = p.out + (size_t)q0 * 1024;
    u32x4 v[4][2];
#pragma unroll
    for (int u = 0; u < 4; ++u)
#pragma unroll
      for (int q = 0; q < 2; ++q) v[u][q] = *(const u32x4*)(src + (size_t)u * 1024 + q * 512 + lane * 8);
#pragma unroll
    for (int u = 0; u < 4; ++u) { f32x4 x[2][2]; float ss = 0.f;
#pragma unroll
      for (int q = 0; q < 2; ++q) { x[q][0] = (f32x4){lo16(v[u][q].x), hi16(v[u][q].x), lo16(v[u][q].y), hi16(v[u][q].y)}; x[q][1] = (f32x4){lo16(v[u][q].z), hi16(v[u][q].z), lo16(v[u][q].w), hi16(v[u][q].w)};
#pragma unroll
        for (int hf = 0; hf < 2; ++hf) ss += x[q][hf][0] * x[q][hf][0] + x[q][hf][1] * x[q][hf][1] + x[q][hf][2] * x[q][hf][2] + x[q][hf][3] * x[q][hf][3]; }
      ss = wsum(ss); const float rstd = rsqrtf(ss * (1.0f / 1024.0f) + EPS);
#pragma unroll
      for (int q = 0; q < 2; ++q)
#pragma unroll
        for (int hf = 0; hf < 2; ++hf) *(f32x4*)(dst + (size_t)u * 1024 + q * 512 + lane * 8 + hf * 4) = x[q][hf] * rstd * g4[q][hf]; }
  }
}

__global__ void __launch_bounds__(512, 2) mega(Params p) {
  extern __shared__ __attribute__((aligned(16))) unsigned char shm[];
  cg::grid_group grid = cg::this_grid();
  LAS unsigned char* lds3 = (LAS unsigned char*)shm;
  unsigned char* ws = p.ws;
  const int G = gridDim.x, c = blockIdx.x;
  volatile LAS unsigned* xbst = (volatile LAS unsigned*)(lds3 + 131072);
  if (threadIdx.x == 0) { xbst[0] = 0u; xbst[1] = 0u; xbst[2] = 0u; xbst[3] = 0u; }
  __syncthreads();
  (void)xcd_barrier_post((unsigned*)(ws + WS_BAR), xbst);
#define XBAR() do { XcdBarrier b_; b_.bar = (unsigned*)(p.ws + WS_BAR); b_.x = xb_xcc_id(); b_.st = (volatile LAS unsigned*)(lds3 + 131072); xcd_barrier(b_); } while (0)
  phase0(p, shm);
  if (p.ws == nullptr) grid.sync();
  XBAR();
#pragma unroll 1
  for (int l = 0; l < 2; ++l) {
    const bool l0 = (l == 0);
    norm_phase(p, l, 0, l0, false);
    XBAR();
    { pg8::Gemm g{(const bf16_t*)(ws + WS_XA), (const bf16_t*)(ws + WS_WIN) + (size_t)l * 2816 * 1024, 1024, 2816, 1024};
      pg8::Sched S; if (l0) S.init(T / 256, 2816, G, c, 0); else S.init(256, 2816, G, c, 1, 32 * 5);
      pg8::EpiWin E{(bf16_t*)(ws + WS_PA), (bf16_t*)(ws + WS_PB), p.in[26] + l * 64, p.in[27] + l * 64, (bf16_t*)(ws + WS_VT), shm + LDS_TP, (float*)(ws + WS_SSQ), (float*)(ws + WS_SSK)};
      pg8::gemm_phase(lds3, g, S, E); }
    XBAR();
    { pg8::Gemm g{(const bf16_t*)(ws + WS_PB), (const bf16_t*)(ws + WS_WUP) + (size_t)l * 1024 * 512, LDPB, 1024, 512};
      pg8::Sched S; S.init(T / 256, 1024, G, c, 0);
      pg8::EpiBf E{(bf16_t*)(ws + WS_XA), LDU, (const float*)(ws + WS_SSQ), (const float*)(ws + WS_SSK)};
      pg8::gemm_phase(lds3, g, S, E); }
    { const int nat = l0 ? 1152 : 1024, nhy = l0 ? 1280 : 1024, tot = nat + 256 + nhy;
      for (int it = c; it < tot; it += G) {
        if (it < 256) ret_state_item(p, l, it, shm);
        else if (it < 256 + nat) attn_item(p, l, 0, it - 256, shm);
        else hy_order_items(p, l, 0, it - 256 - nat, shm);
      } }
    XBAR();
    { const int nat = l0 ? 1152 : 1024, nhy = l0 ? 1280 : 1024, tot = 2 * nat + nhy;
      for (int it = c; it < tot; it += G) {
        if (it < nat) attn_item(p, l, 2, it, shm);
        else if (it < 2 * nat) attn_item(p, l, 1, it - nat, shm);
        else hy_order_items(p, l, 1, it - 2 * nat, shm);
      } }
    XBAR();
    merge_phase(p, l, l0, shm);
    XBAR();
    { pg8::Gemm g{(const bf16_t*)(ws + WS_XA), (const bf16_t*)(ws + WS_WOUT) + (size_t)l * 1024 * 1024, 1024, 1024, 1024};
      pg8::Sched S; S.init(l0 ? T / 256 : 256, 1024, G, c, l0 ? 0 : 1);
      pg8::EpiRes E{p.in[0], p.in[2], (bf16_t*)(ws + WS_XS), (const float*)(ws + WS_MOD) + ((size_t)l * 33 * 6 + 2) * 1024, l0 ? 1 : 0};
      pg8::gemm_phase(lds3, g, S, E); }
    XBAR();
    norm_phase(p, l, 1, false, !l0);
    XBAR();
    { pg8::Gemm g{(const bf16_t*)(ws + WS_XA), (const bf16_t*)(ws + WS_WFI) + (size_t)l * 5632 * 1024, 1024, 5632, 1024};
      pg8::Sched S; S.init(l0 ? T / 256 : 256, 5632, G, c, l0 ? 0 : 1);
      pg8::EpiSwiglu E{(bf16_t*)(ws + WS_H)};
      pg8::gemm_phase(lds3, g, S, E); }
    XBAR();
    { pg8::Gemm g{(const bf16_t*)(ws + WS_H), (const bf16_t*)(ws + WS_WFO) + (size_t)l * 1024 * DFF, DFF, 1024, DFF};
      pg8::Sched S; S.init(l0 ? T / 256 : 256, 1024, G, c, l0 ? 0 : 1);
      pg8::EpiRes E{p.in[0], p.in[2], (bf16_t*)(ws + WS_XS), (const float*)(ws + WS_MOD) + ((size_t)l * 33 * 6 + 5) * 1024, 0};
      pg8::gemm_phase(lds3, g, S, E); }
    XBAR();
  }
  final_phase(p);
}

extern "C" void kernel_launch(void* const* d_in, const int* in_sizes, int n_in, void* d_out, int out_size, void* d_ws, size_t ws_size, hipStream_t stream) {
  static int grid_blocks = 0;
  if (grid_blocks == 0) {
    if (n_in != 33 || ws_size < WS_END) { fprintf(stderr, "kernel_launch: need 33 inputs and %zu bytes of workspace (got %d, %zu)\n", (size_t)WS_END, n_in, ws_size); grid_blocks = -1; return; }
    int dev = 0, cus = 0, per_cu = 0;
    (void)hipGetDevice(&dev);
    (void)hipDeviceGetAttribute(&cus, hipDeviceAttributeMultiprocessorCount, dev);
    if (hipFuncSetAttribute((const void*)mega, hipFuncAttributeMaxDynamicSharedMemorySize, LDS_BYTES) != hipSuccess) { fprintf(stderr, "kernel_launch: hipFuncSetAttribute failed\n"); grid_blocks = -1; return; }
    if (hipOccupancyMaxActiveBlocksPerMultiprocessor(&per_cu, (const void*)mega, 512, LDS_BYTES) != hipSuccess || per_cu < 1) { fprintf(stderr, "kernel_launch: occupancy query gave %d\n", per_cu); per_cu = 1; }
    (void)hipGetLastError();
    grid_blocks = cus * 1;
  }
  if (grid_blocks < 0) return;
  (void)hipMemsetAsync((char*)d_ws + WS_NORM, 0, WS_KREVL - WS_NORM, stream);
  Params p{};
  for (int i = 0; i < 33; ++i) p.in[i] = (const float*)d_in[i];
  p.out = (float*)d_out; p.ws = (unsigned char*)d_ws;
  void* args[] = {&p};
  hipError_t e = hipLaunchCooperativeKernel((const void*)mega, dim3(grid_blocks), dim3(512), args, LDS_BYTES, stream);
  if (e != hipSuccess) fprintf(stderr, "cooperative launch failed: %s (grid %d)\n", hipGetErrorString(e), grid_blocks);
}
```

```cpp
#include <hip/hip_runtime.h>
#include <hip/hip_cooperative_groups.h>
#include <cstdio>
#include <cstdint>
namespace cg = cooperative_groups;

typedef unsigned short bf16_t;
typedef short bf16x8 __attribute__((ext_vector_type(8)));
typedef short s16x4 __attribute__((ext_vector_type(4)));
typedef float f32x4 __attribute__((ext_vector_type(4)));
typedef float f32x16 __attribute__((ext_vector_type(16)));
typedef unsigned u32x4 __attribute__((ext_vector_type(4)));
typedef unsigned u32x2 __attribute__((ext_vector_type(2)));
#define LAS __attribute__((address_space(3)))

constexpr int DM = 1024, NB = 32, SEQ = 2048, NCTX = 256, RPB = 2304, T = NB * RPB;
constexpr int INC = 2720, DFF = 2816;
constexpr int LDPA = 768, LDPB = 1952, LDU = 1024;
constexpr int C_CQ = 0, C_CKV = 256, C_KR = 384, C_RQ = 416, C_RK = 672, C_RV = 928, C_RG = 1184, C_GQ = 1440, C_GK = 1696, C_GV = 1824;
constexpr float EPS = 1e-6f;
constexpr int LDS_TP = 131072 + 64, LDS_BYTES = LDS_TP + 8 * 2560;

constexpr size_t al256(size_t x) { return (x + 255) / 256 * 256; }
constexpr size_t WS_WIN = 0;
constexpr size_t WS_WOUT = WS_WIN + al256((size_t)2 * 2816 * 1024 * 2);
constexpr size_t WS_WFI = WS_WOUT + al256((size_t)2 * 1024 * 1024 * 2);
constexpr size_t WS_WFO = WS_WFI + al256((size_t)2 * 5632 * 1024 * 2);
constexpr size_t WS_WUP = WS_WFO + al256((size_t)2 * 1024 * 2816 * 2);
constexpr size_t WS_MOD = WS_WUP + al256((size_t)2 * 1024 * 512 * 2);
constexpr size_t WS_NORM = WS_MOD + al256((size_t)2 * 33 * 6144 * 4);
constexpr size_t WS_BAR = WS_NORM + al256((size_t)2 * 2 * 512 * 4);
constexpr size_t WS_KREVL = WS_BAR + al256((size_t)3456 * 4);
constexpr size_t WS_KREVC = WS_KREVL + al256((size_t)2 * 512 * 4096 * 2);
constexpr size_t WS_XS = WS_KREVC + al256((size_t)2 * 512 * 512 * 2);
constexpr size_t WS_XA = WS_XS + al256((size_t)T * 1024 * 4);
constexpr size_t WS_PB = WS_XA + al256((size_t)T * 1024 * 2);
constexpr size_t WS_PA = WS_PB + al256((size_t)T * LDPB * 2);
constexpr size_t WS_VT = WS_PA + al256((size_t)T * LDPA * 2);
constexpr size_t WS_X1T = WS_VT + al256((size_t)T * 256 * 2);
constexpr size_t WS_X2T = WS_X1T + al256((size_t)T * 256 * 2);
constexpr size_t WS_RST = WS_X2T + al256((size_t)T * 256 * 2);
constexpr size_t WS_SSQ = WS_RST + al256((size_t)NB * 4 * 2 * 8 * 4096 * 2);
constexpr size_t WS_SSK = WS_SSQ + al256((size_t)T * 4 * 4);
constexpr size_t WS_END = WS_SSK + al256((size_t)T * 4 * 4);
constexpr size_t WS_ZZT = WS_PA;
constexpr size_t WS_YAT = WS_PA + al256((size_t)T * 256 * 2);
constexpr size_t WS_H = WS_PB;
static_assert(WS_H + (size_t)T * DFF * 2 <= WS_RST, "H alias");
static_assert(WS_END <= ((size_t)1 << 30), "workspace over 1 GiB");
static_assert(WS_X1T == WS_VT + (size_t)T * 256 * 2 && WS_X2T == WS_X1T + (size_t)T * 256 * 2, "VT|X1T|X2T consecutive");

struct Params { const float* in[33]; float* out; unsigned char* ws; };

__device__ __forceinline__ float bf2f(bf16_t v) { return __uint_as_float(((unsigned)v) << 16); }
__device__ __forceinline__ bf16_t f2bf(float f) { unsigned u = __float_as_uint(f); u += 0x7FFFu + ((u >> 16) & 1u); return (bf16_t)(u >> 16); }
__device__ __forceinline__ unsigned cvtpk(float lo, float hi) { unsigned r; asm volatile("v_cvt_pk_bf16_f32 %0, %1, %2" : "=v"(r) : "v"(lo), "v"(hi)); return r; }
__device__ __forceinline__ float wsum(float v) { for (int o = 32; o >= 1; o >>= 1) v += __shfl_xor(v, o); return v; }
__device__ __forceinline__ float gsum16(float v) { for (int o = 8; o >= 1; o >>= 1) v += __shfl_xor(v, o); return v; }
__device__ __forceinline__ int opaque_tid() { int t = threadIdx.x; asm volatile("" : "+v"(t)); return t; }
__device__ __forceinline__ float lo16(unsigned w) { return __uint_as_float(w << 16); }
__device__ __forceinline__ float hi16(unsigned w) { return __uint_as_float(w & 0xffff0000u); }


#define XB_TMO      128
#define XB_XCNT(j)  (256  + 64 * (j))
#define XB_XSUB(j)  (1280 + 64 * (j))
#define XB_XGEN(j)  (2304 + 64 * (j))
#define XB_TOP      3328
#define XB_TOPGEN   3392
#define XCD_BAR_WORDS 3456
#define XB_SPIN_CAP (1u << 22)
__device__ __forceinline__ unsigned xb_ld(unsigned* p)              { return __hip_atomic_load(p, __ATOMIC_RELAXED, __HIP_MEMORY_SCOPE_AGENT); }
__device__ __forceinline__ unsigned xb_add(unsigned* p, unsigned v) { return __hip_atomic_fetch_add(p, v, __ATOMIC_RELAXED, __HIP_MEMORY_SCOPE_AGENT); }
__device__ __forceinline__ unsigned xb_xcc_id() { return (unsigned)__builtin_amdgcn_s_getreg((3 << 11) | 20) & 0xFu; }
#define XB_SPIN(cond, bar) do { unsigned _sp = 0; while (cond) { __builtin_amdgcn_s_sleep(1); \
    if ((++_sp & 255u) == 0u) { if (xb_ld(&(bar)[XB_TMO])) break; if (_sp > XB_SPIN_CAP) { atomicAdd(&(bar)[XB_TMO], 1u); break; } } } } while (0)
struct XcdBarrier { unsigned* bar; unsigned x; volatile LAS unsigned* st; };
__device__ __forceinline__ XcdBarrier xcd_barrier_post(unsigned* bar, volatile LAS unsigned* st) {
    XcdBarrier b; b.bar = bar; b.x = xb_xcc_id(); b.st = st;
    if (threadIdx.x == 0) (void)xb_add(&bar[XB_XCNT(b.x)], 1u);
    return b;
}
__device__ __forceinline__ void xcd_barrier_complete(unsigned* bar, unsigned x, unsigned& nloc, unsigned& nx) {
    const unsigned G = gridDim.x * gridDim.y * gridDim.z;
    unsigned sum, cnt, mine, sp = 0u;
    for (;;) {
        sum = 0u; cnt = 0u; mine = 0u;
#pragma unroll
        for (unsigned j = 0; j < 16; ++j) { const unsigned c = xb_ld(&bar[XB_XCNT(j)]); sum += c; cnt += (c > 0u) ? 1u : 0u; mine = (j == x) ? c : mine; }
        if (sum == G) break;
        __builtin_amdgcn_s_sleep(1);
        if ((++sp & 255u) == 0u) { if (xb_ld(&bar[XB_TMO])) break; if (sp > XB_SPIN_CAP) { atomicAdd(&bar[XB_TMO], 1u); break; } }
    }
    nloc = mine > 0u ? mine : 1u; nx = cnt > 0u ? cnt : 1u;
}
__device__ __forceinline__ void xcd_barrier(const XcdBarrier& b) {
    asm volatile("s_waitcnt vmcnt(0)" ::: "memory");
    __syncthreads();
    if (threadIdx.x == 0) {
        unsigned* bar = b.bar;
        __builtin_amdgcn_s_waitcnt(0);
        unsigned nloc = b.st[0], nx = b.st[1];
        if (nloc == 0u) { xcd_barrier_complete(bar, b.x, nloc, nx); b.st[0] = nloc; b.st[1] = nx; }
        const unsigned old = xb_add(&bar[XB_XSUB(b.x)], 1u);
        const unsigned gen = old / nloc;
        if (old + 1u == (gen + 1u) * nloc) {
            __builtin_amdgcn_fence(__ATOMIC_RELEASE, "agent");
            asm volatile("s_waitcnt vmcnt(0)" ::: "memory");
            const unsigned og = xb_add(&bar[XB_TOP], 1u);
            const unsigned tg = og / nx;
            if (og + 1u == (tg + 1u) * nx) xb_add(&bar[XB_TOPGEN], 1u);
            else XB_SPIN(xb_ld(&bar[XB_TOPGEN]) == tg, bar);
            __builtin_amdgcn_fence(__ATOMIC_ACQUIRE, "agent");
            xb_add(&bar[XB_XGEN(b.x)], 1u);
            asm volatile("s_waitcnt vmcnt(0)" ::: "memory");
        } else {
            XB_SPIN(xb_ld(&bar[XB_XGEN(b.x)]) == gen, bar);
            __builtin_amdgcn_fence(__ATOMIC_ACQUIRE, "agent");
            asm volatile("s_waitcnt vmcnt(0)" ::: "memory");
        }
    }
    __syncthreads();
}

namespace pg8 {
constexpr int BM = 256, BK = 64, HALF = 128, HTB = HALF * BK * 2, STAGE_BYTES = 8 * HTB, NXCD = 8, WGM = 8;
__host__ __device__ __forceinline__ int lds_byte(int r, int c) { const int st = (r >> 4) * 2 + (c >> 5), rr = r & 15, cc = c & 31, ob = rr * 64 + cc * 2; return st * 1024 + (ob ^ (((ob >> 9) & 1) << 5)); }
__host__ __device__ __forceinline__ void stage_rc(int b, int& R, int& C) { const int st = b / 1024, sb = b % 1024, swz = sb ^ (((sb >> 9) & 1) << 5); R = (st >> 1) * 16 + swz / 64; C = (st & 1) * 32 + (swz % 64) / 2; }
__host__ __device__ __forceinline__ int perm32(int rho) { const int n = rho >> 4, i = rho & 15; return 8 * (i >> 2) + 4 * n + (i & 3); }
struct Unit { int pm, pn; };
struct Gemm { const bf16_t* A; const bf16_t* Bt; int lda, N, K; };
struct Sched {
    int nM, nN, nwg, G, c, skipctx, extra;
    __device__ void init(int nM_, int N, int G_, int c_, int skip, int extra_ = 0) { nM = nM_; nN = N / BM; nwg = nM * nN; G = G_; c = c_; skipctx = skip; extra = extra_; }
    __device__ bool next(int i, Unit& u) const {
        const long L = (long)i * G + c; if (L >= nwg + extra) return false;
        if (L >= nwg) { const int idx = (int)L - nwg, ci = idx / 5, j = idx - ci * 5; u.pm = ci * 9; u.pn = j < 2 ? 3 + j : (j < 4 ? 4 + j : 10); return true; }
        int wgid = (int)L; { const int q = nwg / NXCD, r = nwg % NXCD, xcd = wgid % NXCD, off = wgid / NXCD; wgid = (xcd < r ? xcd * (q + 1) : r * (q + 1) + (xcd - r) * q) + off; }
        const int nig = WGM * nN, gid = wgid / nig, fm = gid * WGM, gsz = (nM - fm) < WGM ? (nM - fm) : WGM;
        int pm = fm + ((wgid % nig) % gsz); u.pn = (wgid % nig) / gsz;
        if (skipctx) pm = (pm >> 3) * 9 + 1 + (pm & 7);
        u.pm = pm; return true;
    }
};

template <class Epi>
__device__ __forceinline__ void gemm_phase(LAS unsigned char* lds, const Gemm g, const Sched& S, const Epi& E) {
    const int tid = opaque_tid(), wid = __builtin_amdgcn_readfirstlane(tid >> 6), lane = tid & 63, wr = wid >> 2, wc = wid & 3, fr = lane & 15, fq = lane >> 4;
    const int K = g.K, nt = K / BK;
    unsigned voffA[2], voffB[2];
#pragma unroll
    for (int i = 0; i < 2; ++i) { int R, C; stage_rc(tid * 16 + i * 8192, R, C); const int Rb = Epi::PERM ? ((R & ~31) + perm32(R & 31)) : R;
        voffA[i] = (unsigned)(R * g.lda + C) * 2u; voffB[i] = (unsigned)(Rb * K + C) * 2u; }
    const size_t kstep = (size_t)(BK * 2);
    const size_t hstepA = (size_t)HALF * g.lda * 2, hstepB = (size_t)HALF * K * 2;
    const size_t tstepA = 2 * hstepA, tstepB = 2 * hstepB;
    const unsigned ldsw = (unsigned)wid * 1024u;
    const int aoff = lds_byte(wr * 64 + fr, fq * 8), boff = lds_byte(wc * 32 + fr, fq * 8);
#define PG8_SA(b, h) (((b) * 2 + (h)) * HTB)
#define PG8_SB(b, h) ((4 + (b) * 2 + (h)) * HTB)
#define PG8_STAGE(bufoff, gbase, voff) do { _Pragma("unroll") for (int _i = 0; _i < 2; ++_i) \
        __builtin_amdgcn_global_load_lds((const unsigned*)((const char*)(gbase) + (voff)[_i]), (LAS unsigned*)(lds + (bufoff) + ldsw + _i * 8192), 16, 0, 0); } while (0)
#define PG8_LDA(dst, b, h) do { _Pragma("unroll") for (int m = 0; m < 4; ++m) _Pragma("unroll") for (int k = 0; k < 2; ++k) dst[m][k] = *(const LAS bf16x8*)(lds + PG8_SA(b, h) + aoff + m * 2048 + k * 1024); } while (0)
#define PG8_LDB(dst, b, h) do { _Pragma("unroll") for (int n = 0; n < 2; ++n) _Pragma("unroll") for (int k = 0; k < 2; ++k) dst[n][k] = *(const LAS bf16x8*)(lds + PG8_SB(b, h) + boff + n * 2048 + k * 1024); } while (0)
#define PG8_MMA(ai, bj, At, Bt) do { __builtin_amdgcn_s_setprio(1); _Pragma("unroll") for (int m = 0; m < 4; ++m) _Pragma("unroll") for (int n = 0; n < 2; ++n) _Pragma("unroll") for (int k = 0; k < 2; ++k) \
        acc[ai][bj][m][n] = __builtin_amdgcn_mfma_f32_16x16x32_bf16(Bt[n][k], At[m][k], acc[ai][bj][m][n], 0, 0, 0); __builtin_amdgcn_s_setprio(0); } while (0)
#define PG8_WAIT_V(n) asm volatile("s_waitcnt vmcnt(" #n ")" ::: "memory")
#define PG8_WAIT_L(n) asm volatile("s_waitcnt lgkmcnt(" #n ")" ::: "memory")
#define PG8_BAR __builtin_amdgcn_s_barrier()
#define PG8_SCHED __builtin_amdgcn_sched_barrier(0)
    Unit cur, nxt; int ui = 0;
    if (!S.next(0, cur)) return;
    f32x4 acc[2][2][4][2];
#pragma unroll
    for (int a = 0; a < 2; ++a)
#pragma unroll
        for (int b = 0; b < 2; ++b)
#pragma unroll
            for (int m = 0; m < 4; ++m)
#pragma unroll
                for (int n = 0; n < 2; ++n) acc[a][b][m][n] = (f32x4){0.f, 0.f, 0.f, 0.f};
    bf16x8 At[4][2], B0[2][2], B1[2][2];
    const char* cA = (const char*)g.A + (size_t)cur.pm * tstepA; const char* cB = (const char*)g.Bt + (size_t)cur.pn * tstepB;
    PG8_STAGE(PG8_SB(0, 0), cB, voffB); PG8_STAGE(PG8_SA(0, 0), cA, voffA); PG8_STAGE(PG8_SB(0, 1), cB + hstepB, voffB); PG8_STAGE(PG8_SA(0, 1), cA + hstepA, voffA);
    if (wr == 1) PG8_BAR;
    PG8_WAIT_V(4); PG8_BAR;
    PG8_STAGE(PG8_SB(1, 0), cB + kstep, voffB); PG8_STAGE(PG8_SA(1, 0), cA + kstep, voffA); PG8_STAGE(PG8_SB(1, 1), cB + hstepB + kstep, voffB);
    PG8_WAIT_V(6); PG8_BAR;
    for (;;) {
        const bool has_next = S.next(ui + 1, nxt);
        const char* nA = has_next ? (const char*)g.A + (size_t)nxt.pm * tstepA : cA; const char* nB = has_next ? (const char*)g.Bt + (size_t)nxt.pn * tstepB : cB;
        for (int t = 0; t < nt; t += 2) {
            const bool last = (t == nt - 2);
            const char* a1 = cA + (size_t)(t + 1) * kstep;
            const char* a2 = last ? nA : cA + (size_t)(t + 2) * kstep; const char* b2 = last ? nB : cB + (size_t)(t + 2) * kstep;
            const char* a3 = a2 + kstep; const char* b3 = b2 + kstep;
            PG8_LDB(B0, 0, 0); PG8_SCHED; PG8_LDA(At, 0, 0); PG8_STAGE(PG8_SA(1, 1), a1 + hstepA, voffA);
            PG8_WAIT_L(8); PG8_BAR; PG8_WAIT_L(0); PG8_MMA(0, 0, At, B0); PG8_BAR; PG8_SCHED;
            PG8_LDB(B1, 0, 1); PG8_STAGE(PG8_SB(0, 0), b2, voffB);
            PG8_BAR; PG8_WAIT_L(0); PG8_MMA(0, 1, At, B1); PG8_BAR;
            PG8_LDA(At, 0, 1); PG8_STAGE(PG8_SA(0, 0), a2, voffA);
            PG8_BAR; PG8_WAIT_L(0); PG8_MMA(1, 0, At, B0); PG8_BAR; PG8_SCHED;
            PG8_STAGE(PG8_SB(0, 1), b2 + hstepB, voffB);
            PG8_WAIT_V(6); PG8_BAR; PG8_MMA(1, 1, At, B1); PG8_BAR;
            PG8_LDB(B0, 1, 0); PG8_SCHED; PG8_LDA(At, 1, 0); PG8_STAGE(PG8_SA(0, 1), a2 + hstepA, voffA);
            PG8_WAIT_L(8); PG8_BAR; PG8_WAIT_L(0); PG8_MMA(0, 0, At, B0); PG8_BAR; PG8_SCHED;
            PG8_LDB(B1, 1, 1); PG8_STAGE(PG8_SB(1, 0), b3, voffB);
            PG8_BAR; PG8_WAIT_L(0); PG8_MMA(0, 1, At, B1); PG8_BAR;
            PG8_LDA(At, 1, 1); PG8_STAGE(PG8_SA(1, 0), a3, voffA);
            PG8_BAR; PG8_WAIT_L(0); PG8_MMA(1, 0, At, B0); PG8_BAR; PG8_SCHED;
            PG8_STAGE(PG8_SB(1, 1), b3 + hstepB, voffB);
            PG8_WAIT_V(6); PG8_BAR; PG8_MMA(1, 1, At, B1); PG8_BAR;
        }
        E(acc, cur, wr, wc, fr, fq);
        if (!has_next) break;
#pragma unroll
        for (int a = 0; a < 2; ++a)
#pragma unroll
            for (int b = 0; b < 2; ++b)
#pragma unroll
                for (int m = 0; m < 4; ++m)
#pragma unroll
                    for (int n = 0; n < 2; ++n) acc[a][b][m][n] = (f32x4){0.f, 0.f, 0.f, 0.f};
        cur = nxt; cA = nA; cB = nB; ++ui;
    }
    PG8_WAIT_V(0);
    if (wr == 0) PG8_BAR;
    PG8_BAR;
#undef PG8_SA
#undef PG8_SB
#undef PG8_STAGE
#undef PG8_LDA
#undef PG8_LDB
#undef PG8_MMA
#undef PG8_WAIT_V
#undef PG8_WAIT_L
#undef PG8_BAR
#undef PG8_SCHED
}

struct EpiWin {
    static constexpr bool PERM = true;
    bf16_t* PA; bf16_t* PB; const float* gq; const float* gk; bf16_t* HT; unsigned char* lds_tp;
    float* SSQ; float* SSK;
    __device__ __forceinline__ void operator()(const f32x4 (&acc)[2][2][4][2], const Unit& u, int wr, int wc, int fr, int fq) const {
        int oz = 0; asm volatile("" : "+v"(oz));
        const int row0 = u.pm * BM + wr * 64 + fr + oz, pn = u.pn;
        const int sub = u.pm % 9;
        if (pn < 3) {
            bf16_t* patch = (bf16_t*)(lds_tp + (wr * 4 + wc) * 2560);
            bf16_t* OT = HT + (size_t)pn * ((size_t)T * 256);
            const int lane_ = fr + 16 * fq, ch = lane_ >> 1, hf = lane_ & 1;
#pragma unroll
            for (int ai = 0; ai < 2; ++ai)
#pragma unroll
                for (int bj = 0; bj < 2; ++bj)
#pragma unroll
                    for (int mh = 0; mh < 2; ++mh) {
#pragma unroll
                        for (int mm = 0; mm < 2; ++mm) { const int m = mh * 2 + mm;
#pragma unroll
                            for (int n = 0; n < 2; ++n)
#pragma unroll
                                for (int j = 0; j < 4; ++j) patch[(8 * fq + 4 * n + j) * 40 + 16 * mm + fr] = f2bf(acc[ai][bj][m][n][j]); }
                        asm volatile("" ::: "memory");
                        const u32x4 w0 = *(const u32x4*)(patch + ch * 40 + 16 * hf), w1 = *(const u32x4*)(patch + ch * 40 + 16 * hf + 8);
                        bf16_t* dst = OT + (size_t)(bj * HALF + wc * 32 + ch) * T + (size_t)u.pm * BM + ai * HALF + wr * 64 + mh * 32 + 16 * hf + oz;
                        *(u32x4*)dst = w0; *(u32x4*)(dst + 8) = w1;
                        asm volatile("" ::: "memory"); }
            return;
        }
        const bool headtile = (pn == 5 || pn == 6 || pn == 9 || (pn == 10 && wc < 2));
        if (!headtile) {
            bf16_t* dstb; int ld, cbase, lim;
            if (pn < 3) { dstb = PA; ld = LDPA; cbase = pn * 256; lim = 256; }
            else { dstb = PB; ld = LDPB; lim = 256; cbase = pn == 3 ? C_CQ : (pn == 4 ? C_CKV : (pn == 7 ? C_RV : (pn == 8 ? C_RG : C_GV - 128))); if (pn == 4) lim = 160; }
#pragma unroll
            for (int ai = 0; ai < 2; ++ai)
#pragma unroll
                for (int m = 0; m < 4; ++m) { const size_t row = (size_t)(row0 + ai * HALF + m * 16);
                    if (pn == 3 || pn == 4) {
                        float ss = 0.f;
#pragma unroll
                        for (int n = 0; n < 2; ++n)
#pragma unroll
                            for (int j = 0; j < 4; ++j) { ss += acc[ai][0][m][n][j] * acc[ai][0][m][n][j]; if (pn == 3) ss += acc[ai][1][m][n][j] * acc[ai][1][m][n][j]; }
                        { auto r16 = __builtin_amdgcn_permlane16_swap(__float_as_uint(ss), __float_as_uint(ss), false, false); ss = __uint_as_float(r16[0]) + __uint_as_float(r16[1]);
                          auto r32_ = __builtin_amdgcn_permlane32_swap(__float_as_uint(ss), __float_as_uint(ss), false, false); ss = __uint_as_float(r32_[0]) + __uint_as_float(r32_[1]); }
                        if (fq == 0) (pn == 3 ? SSQ : SSK)[row * 4 + wc] = ss; }
#pragma unroll
                    for (int bj = 0; bj < 2; ++bj) { f32x4 v0 = acc[ai][bj][m][0], v1 = acc[ai][bj][m][1];
                        if (pn == 4 && bj == 1 && wc == 0 && sub != 0) {
                            const float pos = (fq & 1) ? (float)(16 * m + fr) : (float)((sub - 1) * 4 + 2 * ai + wr);
#pragma unroll
                            for (int n = 0; n < 2; ++n)
#pragma unroll
                                for (int j = 0; j < 4; ++j) { const float x = n ? v1[j] : v0[j];
                                    auto rr = __builtin_amdgcn_permlane32_swap(__float_as_uint(x), __float_as_uint(x), false, false);
                                    const float x1 = __uint_as_float(rr[0]), x2 = __uint_as_float(rr[1]);
                                    const float a_ = pos * __builtin_amdgcn_exp2f(-(float)(4 * n + j) * (13.287712379549449f / 8.0f)), cs = __cosf(a_), sn = __sinf(a_);
                                    const float y = (fq < 2) ? x1 * cs - x2 * sn : x2 * cs + x1 * sn;
                                    if (n) v1[j] = y; else v0[j] = y; } }
                        u32x4 w; w.x = cvtpk(v0[0], v0[1]); w.y = cvtpk(v0[2], v0[3]); w.z = cvtpk(v1[0], v1[1]); w.w = cvtpk(v1[2], v1[3]);
                        int cl = bj * HALF + wc * 32 + 8 * fq;
                        if (pn == 10) cl = 128 + (wc - 2) * 64 + bj * 32 + 8 * fq;
                        if (cl < lim) *(u32x4*)(dstb + row * ld + cbase + cl) = w; } }
            return;
        }
        const bool donorm = (pn >= 9); const float kscale = (pn == 6) ? 0.125f : 1.0f;
        const int cbase = (pn == 5 ? C_RQ : (pn == 6 ? C_RK : (pn == 9 ? C_GQ : C_GK))) + 64 * wc + 8 * fq;
        const float* gp = (pn == 9) ? gq : gk;
        f32x4 g4[2][2];
#pragma unroll
        for (int bj = 0; bj < 2; ++bj)
#pragma unroll
            for (int n = 0; n < 2; ++n) g4[bj][n] = donorm ? *(const f32x4*)(gp + 32 * bj + 8 * fq + 4 * n) : (f32x4){1.f, 1.f, 1.f, 1.f};
        float inv[8];
#pragma unroll
        for (int e = 0; e < 8; ++e) inv[e] = exp2f(-(float)((8 * fq + e) & 15) * (13.287712379549449f / 16.0f));
#pragma unroll
        for (int ai = 0; ai < 2; ++ai)
#pragma unroll
            for (int m = 0; m < 4; ++m) { const size_t row = (size_t)(row0 + ai * HALF + m * 16);
                f32x4 x1[2] = {acc[ai][0][m][0], acc[ai][0][m][1]}, x2[2] = {acc[ai][1][m][0], acc[ai][1][m][1]};
                if (donorm) { float ss = 0.f;
#pragma unroll
                    for (int n = 0; n < 2; ++n)
#pragma unroll
                        for (int j = 0; j < 4; ++j) ss += x1[n][j] * x1[n][j] + x2[n][j] * x2[n][j];
                    ss += __shfl_xor(ss, 16); ss += __shfl_xor(ss, 32);
                    const float rstd = rsqrtf(ss * (1.0f / 64.0f) + EPS);
#pragma unroll
                    for (int n = 0; n < 2; ++n) { x1[n] = x1[n] * rstd * g4[0][n]; x2[n] = x2[n] * rstd * g4[1][n]; } }
                const float pos = (fq < 2) ? (float)((sub - 1) * 4 + 2 * ai + wr) : (float)(16 * m + fr);
                unsigned o1[4], o2[4];
#pragma unroll
                for (int n = 0; n < 2; ++n)
#pragma unroll
                    for (int jp = 0; jp < 2; ++jp) { float r1[2], r2[2];
#pragma unroll
                        for (int e = 0; e < 2; ++e) { const int j = 2 * jp + e; float cs = 1.f, sn = 0.f;
                            if (sub != 0) { const float a_ = pos * inv[4 * n + j]; cs = __cosf(a_); sn = __sinf(a_); }
                            const float a1 = x1[n][j] * kscale, a2 = x2[n][j] * kscale;
                            r1[e] = a1 * cs - a2 * sn; r2[e] = a2 * cs + a1 * sn; }
                        o1[2 * n + jp] = cvtpk(r1[0], r1[1]); o2[2 * n + jp] = cvtpk(r2[0], r2[1]); }
                *(u32x4*)(PB + row * LDPB + cbase) = (u32x4){o1[0], o1[1], o1[2], o1[3]};
                *(u32x4*)(PB + row * LDPB + cbase + 32) = (u32x4){o2[0], o2[1], o2[2], o2[3]}; }
    }
};
struct EpiBf {
    static constexpr bool PERM = true;
    bf16_t* O; int ldc; const float* SSQ; const float* SSK;
    __device__ __forceinline__ void operator()(const f32x4 (&acc)[2][2][4][2], const Unit& u, int wr, int wc, int fr, int fq) const {
        int oz = 0; asm volatile("" : "+v"(oz));
        const int row0 = u.pm * BM + wr * 64 + fr + oz, col0 = u.pn * BM + wc * 32 + 8 * fq;
        int cls[2];
#pragma unroll
        for (int bj = 0; bj < 2; ++bj) { const int n = col0 + bj * HALF; cls[bj] = n < 384 ? 0 : (n < 768 ? ((n - 384) % 96 < 64 ? 1 : 2) : 1); }
        float rq[8], rk[8];
        { u32x4 t[8];
#pragma unroll
          for (int i = 0; i < 8; ++i) t[i] = *(const u32x4*)(SSQ + (size_t)(row0 + (i >> 2) * HALF + (i & 3) * 16) * 4);
#pragma unroll
          for (int i = 0; i < 8; ++i) rq[i] = rsqrtf((__uint_as_float(t[i].x) + __uint_as_float(t[i].y) + __uint_as_float(t[i].z) + __uint_as_float(t[i].w)) * (1.0f / 256.0f) + EPS);
#pragma unroll
          for (int i = 0; i < 8; ++i) t[i] = *(const u32x4*)(SSK + (size_t)(row0 + (i >> 2) * HALF + (i & 3) * 16) * 4);
#pragma unroll
          for (int i = 0; i < 8; ++i) rk[i] = rsqrtf((__uint_as_float(t[i].x) + __uint_as_float(t[i].y) + __uint_as_float(t[i].z) + __uint_as_float(t[i].w)) * (1.0f / 128.0f) + EPS); }
#pragma unroll
        for (int ai = 0; ai < 2; ++ai)
#pragma unroll
            for (int m = 0; m < 4; ++m) { bf16_t* rowp = O + (size_t)(row0 + ai * HALF + m * 16) * ldc + col0;
#pragma unroll
                for (int bj = 0; bj < 2; ++bj) { const float sc = cls[bj] == 0 ? rq[ai * 4 + m] : (cls[bj] == 1 ? rk[ai * 4 + m] : 1.0f);
                    const f32x4 v0 = acc[ai][bj][m][0] * sc, v1 = acc[ai][bj][m][1] * sc;
                    u32x4 w; w.x = cvtpk(v0[0], v0[1]); w.y = cvtpk(v0[2], v0[3]); w.z = cvtpk(v1[0], v1[1]); w.w = cvtpk(v1[2], v1[3]);
                    *(u32x4*)(rowp + bj * HALF) = w; } }
    }
};
struct EpiSwiglu {
    static constexpr bool PERM = true;
    bf16_t* H;
    __device__ __forceinline__ void operator()(const f32x4 (&acc)[2][2][4][2], const Unit& u, int wr, int wc, int fr, int fq) const {
        const int row0 = u.pm * BM + wr * 64 + fr, col0 = u.pn * 128 + wc * 32 + 8 * fq;
#pragma unroll
        for (int ai = 0; ai < 2; ++ai)
#pragma unroll
            for (int m = 0; m < 4; ++m) { bf16_t* rowp = H + (size_t)(row0 + ai * HALF + m * 16) * DFF + col0;
                float hv[8];
#pragma unroll
                for (int n = 0; n < 2; ++n)
#pragma unroll
                    for (int j = 0; j < 4; ++j) { const float a = acc[ai][0][m][n][j], gg = acc[ai][1][m][n][j]; hv[n * 4 + j] = a * __builtin_amdgcn_rcpf(1.0f + __expf(-a)) * gg; }
                u32x4 w; w.x = cvtpk(hv[0], hv[1]); w.y = cvtpk(hv[2], hv[3]); w.z = cvtpk(hv[4], hv[5]); w.w = cvtpk(hv[6], hv[7]);
                *(u32x4*)rowp = w; }
    }
};
struct EpiRes {
    static constexpr bool PERM = true;
    const float* x_in; const float* ctx_in; bf16_t* XS; const float* gate; int from_inputs;
    __device__ __forceinline__ void operator()(const f32x4 (&acc)[2][2][4][2], const Unit& u, int wr, int wc, int fr, int fq) const {
        const int b = u.pm / 9, sub = u.pm - b * 9;
        const float* basef = sub == 0 ? ctx_in + (size_t)b * 256 * 1024 : x_in + ((size_t)b * 2048 + (size_t)(sub - 1) * 256) * 1024;
        bf16_t* outp = XS + (size_t)u.pm * 256 * 1024;
        const float* gp = gate + (size_t)(sub == 0 ? 32 : b) * 6144;
        int oz = 0; asm volatile("" : "+v"(oz));
        const int rl0 = wr * 64 + fr + oz, col0 = u.pn * BM + wc * 32 + 8 * fq + oz;
        f32x4 gv[2][2];
#pragma unroll
        for (int bj = 0; bj < 2; ++bj)
#pragma unroll
            for (int n = 0; n < 2; ++n) gv[bj][n] = *(const f32x4*)(gp + col0 + bj * HALF + n * 4);
        if (from_inputs) {
#pragma unroll
          for (int ai = 0; ai < 2; ++ai)
#pragma unroll
            for (int mp = 0; mp < 2; ++mp) {
              f32x4 bs[2][2][2];
#pragma unroll
              for (int mm = 0; mm < 2; ++mm) { const size_t off = (size_t)(rl0 + ai * HALF + (mp * 2 + mm) * 16) * 1024 + col0;
#pragma unroll
                for (int bj = 0; bj < 2; ++bj)
#pragma unroll
                    for (int n = 0; n < 2; ++n) bs[mm][bj][n] = *(const f32x4*)(basef + off + bj * HALF + n * 4); }
#pragma unroll
              for (int mm = 0; mm < 2; ++mm) { const size_t off = (size_t)(rl0 + ai * HALF + (mp * 2 + mm) * 16) * 1024 + col0;
#pragma unroll
                for (int bj = 0; bj < 2; ++bj) { const f32x4 v0 = bs[mm][bj][0] + gv[bj][0] * acc[ai][bj][mp * 2 + mm][0], v1 = bs[mm][bj][1] + gv[bj][1] * acc[ai][bj][mp * 2 + mm][1];
                    u32x4 w; w.x = cvtpk(v0[0], v0[1]); w.y = cvtpk(v0[2], v0[3]); w.z = cvtpk(v1[0], v1[1]); w.w = cvtpk(v1[2], v1[3]); *(u32x4*)(outp + off + bj * HALF) = w; } }
              asm volatile("" ::: "memory"); }
        } else {
#pragma unroll
          for (int ai = 0; ai < 2; ++ai) {
              u32x4 bs[4][2];
#pragma unroll
              for (int m = 0; m < 4; ++m) { const size_t off = (size_t)(rl0 + ai * HALF + m * 16) * 1024 + col0;
#pragma unroll
                for (int bj = 0; bj < 2; ++bj) bs[m][bj] = *(const u32x4*)(outp + off + bj * HALF); }
#pragma unroll
              for (int m = 0; m < 4; ++m) { const size_t off = (size_t)(rl0 + ai * HALF + m * 16) * 1024 + col0;
#pragma unroll
                for (int bj = 0; bj < 2; ++bj) { const u32x4 bw = bs[m][bj];
                    const f32x4 b0 = {lo16(bw.x), hi16(bw.x), lo16(bw.y), hi16(bw.y)}, b1 = {lo16(bw.z), hi16(bw.z), lo16(bw.w), hi16(bw.w)};
                    const f32x4 v0 = b0 + gv[bj][0] * acc[ai][bj][m][0], v1 = b1 + gv[bj][1] * acc[ai][bj][m][1];
                    u32x4 w; w.x = cvtpk(v0[0], v0[1]); w.y = cvtpk(v0[2], v0[3]); w.z = cvtpk(v1[0], v1[1]); w.w = cvtpk(v1[2], v1[3]); *(u32x4*)(outp + off + bj * HALF) = w; } }
              asm volatile("" ::: "memory"); }
        }
    }
};
}

namespace att {
constexpr int KVBLK = 64;
constexpr size_t SHM_V = 64 * 64 * 2, SHM_K = 64 * 128 * 2;
#define KSWZ(row, colB) ((row) * 256 + ((colB) ^ (((row) & 7) << 4)))
#define SBAR() __builtin_amdgcn_sched_barrier(0)
__device__ __forceinline__ int crow(int r, int hi) { return (r & 3) + 8 * (r >> 2) + 4 * hi; }
__device__ __forceinline__ void partialSM(f32x16& p0, f32x16& p1, float& m_reg, float& mn, float& alpha, float C, float thr) {
  float pmax = p0[0];
#pragma unroll
  for (int r = 1; r < 16; ++r) pmax = fmaxf(pmax, p0[r]);
#pragma unroll
  for (int r = 0; r < 16; ++r) pmax = fmaxf(pmax, p1[r]);
  { auto rr = __builtin_amdgcn_permlane32_swap(__float_as_uint(pmax), __float_as_uint(pmax), false, false);
    pmax = fmaxf(__uint_as_float(rr[0]), __uint_as_float(rr[1])); }
  if (__builtin_expect(__all(pmax - m_reg <= thr), 1)) { mn = m_reg; alpha = 1.f; }
  else { mn = fmaxf(m_reg, pmax); alpha = __builtin_amdgcn_exp2f((m_reg - mn) * C); m_reg = mn; }
  float mnC = -mn * C;
#pragma unroll
  for (int r = 0; r < 16; ++r) p0[r] = fmaf(p0[r], C, mnC);
#pragma unroll
  for (int r = 0; r < 16; ++r) p1[r] = fmaf(p1[r], C, mnC);
#pragma unroll
  for (int r = 0; r < 16; ++r) p0[r] = __builtin_amdgcn_exp2f(p0[r]);
}
#define PK4(P, BASE, OUT) do { unsigned a0 = cvtpk(P[BASE + 0], P[BASE + 1]), a1 = cvtpk(P[BASE + 2], P[BASE + 3]);   \
    unsigned b0 = cvtpk(P[BASE + 4], P[BASE + 5]), b1 = cvtpk(P[BASE + 6], P[BASE + 7]);                              \
    auto r0 = __builtin_amdgcn_permlane32_swap(a0, b0, false, false); auto r1 = __builtin_amdgcn_permlane32_swap(a1, b1, false, false); \
    u32x4 w = {r0[0], r1[0], r0[1], r1[1]}; OUT = *reinterpret_cast<bf16x8*>(&w); } while (0)
__device__ __forceinline__ void finishSM(f32x16& p0, f32x16& p1, float alpha, float& l_reg, bf16x8& pa0, bf16x8& pa1, bf16x8& pa2, bf16x8& pa3) {
#pragma unroll
  for (int r = 0; r < 16; ++r) p1[r] = __builtin_amdgcn_exp2f(p1[r]);
  float ps = 0;
#pragma unroll
  for (int r = 0; r < 16; ++r) ps += p0[r];
#pragma unroll
  for (int r = 0; r < 16; ++r) ps += p1[r];
  { auto rr = __builtin_amdgcn_permlane32_swap(__float_as_uint(ps), __float_as_uint(ps), false, false);
    ps = __uint_as_float(rr[0]) + __uint_as_float(rr[1]); }
  l_reg = l_reg * alpha + ps;
  PK4(p0, 0, pa0); PK4(p0, 8, pa1); PK4(p1, 0, pa2); PK4(p1, 8, pa3);
}
__device__ __forceinline__ void finishRET(f32x16& p0, f32x16& p1, int n, int key0, int hi, float lgf, float lgb, int pre, int Lr, bf16x8& pa0, bf16x8& pa1, bf16x8& pa2, bf16x8& pa3) {
  if (key0 < pre) {
#pragma unroll
    for (int r = 0; r < 16; ++r) { const int k0 = key0 + crow(r, hi), k1 = k0 + 32;
      p0[r] *= __builtin_amdgcn_exp2f(lgf * (float)(n + pre - k0)) + __builtin_amdgcn_exp2f(lgb * (float)(Lr + k0 - n));
      p1[r] *= __builtin_amdgcn_exp2f(lgf * (float)(n + pre - k1)) + __builtin_amdgcn_exp2f(lgb * (float)(Lr + k1 - n)); }
  } else {
#pragma unroll
    for (int r = 0; r < 16; ++r) { const int d0 = n + pre - (key0 + crow(r, hi)), d1 = d0 - 32;
      const float f0 = (float)d0, f1 = (float)d1;
      float w0 = __builtin_amdgcn_exp2f(d0 > 0 ? lgf * f0 : -lgb * f0); if (d0 == 0) w0 = 2.f;
      float w1 = __builtin_amdgcn_exp2f(d1 > 0 ? lgf * f1 : -lgb * f1); if (d1 == 0) w1 = 2.f;
      p0[r] *= w0; p1[r] *= w1; }
  }
  PK4(p0, 0, pa0); PK4(p0, 8, pa1); PK4(p1, 0, pa2); PK4(p1, 8, pa3);
}
template <int ND>
__device__ __forceinline__ void qkt(f32x16& p0, f32x16& p1, const bf16_t* Ks, const bf16x8* qr, int r32, int hi) {
  p0 = f32x16{}; p1 = f32x16{};
#pragma unroll
  for (int d0 = 0; d0 < ND; ++d0) { int cb = (d0 * 16 + hi * 8) * 2;
    bf16x8 b0 = *reinterpret_cast<const bf16x8*>((const char*)Ks + KSWZ(r32, cb));
    bf16x8 b1 = *reinterpret_cast<const bf16x8*>((const char*)Ks + KSWZ(32 + r32, cb));
    p0 = __builtin_amdgcn_mfma_f32_32x32x16_bf16(b0, qr[d0], p0, 0, 0, 0);
    p1 = __builtin_amdgcn_mfma_f32_32x32x16_bf16(b1, qr[d0], p1, 0, 0, 0); }
}
__device__ __forceinline__ int v_st(int k, int c) { const int kk = (k & ~0xC) | ((k & 4) << 1) | ((k & 8) >> 1); return ((kk >> 3) * 2 + (c >> 5)) * 512 + ((kk & 7) * 32 + (c & 31)) * 2; }
__device__ __forceinline__ int v_rd_base(int lane) { return ((lane & 3) << 3) | (((lane >> 2) & 3) << 6) | (((lane >> 4) & 1) << 5) | (((lane >> 5) & 1) << 8); }
constexpr int v_rd_off(int d0, int ks, int half) { return d0 * 512 + ks * 2048 + half * 1024; }
template <int OFF> __device__ __forceinline__ s16x4 tr_read(int vb) {
  s16x4 r; asm volatile("ds_read_b64_tr_b16 %0, %1 offset:%2" : "=&v"(r) : "v"(vb), "i"(OFF) : "memory"); return r;
}
template <int D0> __device__ __forceinline__ void pv_one(f32x16& od, int vb, bf16x8 pa0, bf16x8 pa1, bf16x8 pa2, bf16x8 pa3) {
  const s16x4 l0 = tr_read<v_rd_off(D0, 0, 0)>(vb), h0 = tr_read<v_rd_off(D0, 0, 1)>(vb), l1 = tr_read<v_rd_off(D0, 1, 0)>(vb), h1 = tr_read<v_rd_off(D0, 1, 1)>(vb);
  const s16x4 l2 = tr_read<v_rd_off(D0, 2, 0)>(vb), h2 = tr_read<v_rd_off(D0, 2, 1)>(vb), l3 = tr_read<v_rd_off(D0, 3, 0)>(vb), h3 = tr_read<v_rd_off(D0, 3, 1)>(vb);
  asm volatile("s_waitcnt lgkmcnt(0)" ::: "memory"); SBAR();
#define PKV(L, H) (bf16x8){L[0], L[1], L[2], L[3], H[0], H[1], H[2], H[3]}
  od = __builtin_amdgcn_mfma_f32_32x32x16_bf16(pa0, PKV(l0, h0), od, 0, 0, 0);
  od = __builtin_amdgcn_mfma_f32_32x32x16_bf16(pa1, PKV(l1, h1), od, 0, 0, 0);
  od = __builtin_amdgcn_mfma_f32_32x32x16_bf16(pa2, PKV(l2, h2), od, 0, 0, 0);
  od = __builtin_amdgcn_mfma_f32_32x32x16_bf16(pa3, PKV(l3, h3), od, 0, 0, 0);
#undef PKV
}
__device__ __forceinline__ void pv_d0(f32x16* o, int vb, bf16x8 pa0, bf16x8 pa1, bf16x8 pa2, bf16x8 pa3) {
  pv_one<0>(o[0], vb, pa0, pa1, pa2, pa3); pv_one<1>(o[1], vb, pa0, pa1, pa2, pa3);
}

template <int DK, int MODE, bool ROPEQ>
__device__ __forceinline__ void attn_body(const bf16_t* Qb, int ldq, const bf16_t* Kh, const bf16_t* Vh, int ldk, bf16_t* Ob, int ldo, int seq, char* lds,
                                          float C, float thr, int qpos0, float lgf, float lgb, int pre, int Lr, const bf16_t* Sf = nullptr, const bf16_t* Sb = nullptr) {
  constexpr int ND = DK / 16;
  const int tid = opaque_tid(), wid = tid >> 6, lane = tid & 63, r32 = lane & 31, hi = lane >> 5;
  bf16_t* V_lds = (bf16_t*)lds; bf16_t* K_lds = (bf16_t*)(lds + 2 * SHM_V);
  float* wsp = (float*)(lds + 2 * SHM_V + 2 * SHM_K) + wid * 64; float* li_l = wsp; float* al_l = wsp + 32;
  float m_reg = -1e30f, l_reg = 0; f32x16 o[2] = {}; bf16x8 qr[ND];
  const bf16_t* Qw = Qb + (long)(wid * 32 + r32) * ldq + hi * 8;
#pragma unroll
  for (int d0 = 0; d0 < ND; ++d0) qr[d0] = *reinterpret_cast<const bf16x8*>(Qw + d0 * 16);
  const int npos = qpos0 + wid * 32 + r32;
  if constexpr (ROPEQ) {
    const float pos = hi ? (float)(npos & 63) : (float)(npos >> 6);
    u32x4 w1 = *reinterpret_cast<u32x4*>(&qr[4]), w2 = *reinterpret_cast<u32x4*>(&qr[5]);
    unsigned a1[4] = {w1.x, w1.y, w1.z, w1.w}, a2[4] = {w2.x, w2.y, w2.z, w2.w};
#pragma unroll
    for (int jj = 0; jj < 4; ++jj) {
      float x1l = lo16(a1[jj]), x1h = hi16(a1[jj]), x2l = lo16(a2[jj]), x2h = hi16(a2[jj]);
      float sl, cl, sh, ch;
      { const float a0_ = pos * exp2f(-(float)(2 * jj) * (13.287712379549449f / 8.0f)), a1_ = pos * exp2f(-(float)(2 * jj + 1) * (13.287712379549449f / 8.0f));
        sl = __sinf(a0_); cl = __cosf(a0_); sh = __sinf(a1_); ch = __cosf(a1_); }
      a1[jj] = cvtpk(x1l * cl - x2l * sl, x1h * ch - x2h * sh);
      a2[jj] = cvtpk(x2l * cl + x1l * sl, x2h * ch + x1h * sh);
    }
    w1 = (u32x4){a1[0], a1[1], a1[2], a1[3]}; w2 = (u32x4){a2[0], a2[1], a2[2], a2[3]};
    qr[4] = *reinterpret_cast<bf16x8*>(&w1); qr[5] = *reinterpret_cast<bf16x8*>(&w2);
  }
  const int sr = tid >> 4, sc = (tid & 15) * 8;
  const int vk = tid >> 3, vc = (tid & 7) * 8, vst0 = v_st(vk, vc);
  const int vb0 = (int)(uintptr_t)V_lds + v_rd_base(lane);
  struct { bf16x8 vs0, ks0, ks1; } sr_[2];
#define SLOAD(i, k0) do { sr_[i].vs0 = *reinterpret_cast<const bf16x8*>(&Vh[(long)((k0) + vk) * ldk + vc]); \
    sr_[i].ks0 = *reinterpret_cast<const bf16x8*>(&Kh[(long)((k0) + sr) * ldk + sc]); sr_[i].ks1 = *reinterpret_cast<const bf16x8*>(&Kh[(long)((k0) + 32 + sr) * ldk + sc]); } while (0)
#define SWRITE(b, i) do { *(bf16x8*)((char*)V_lds + (b) * SHM_V + vst0) = sr_[i].vs0; int kc = sc * 2;               \
    *(bf16x8*)((char*)K_lds + (b) * SHM_K + KSWZ(sr, kc)) = sr_[i].ks0;                       \
    *(bf16x8*)((char*)K_lds + (b) * SHM_K + KSWZ(32 + sr, kc)) = sr_[i].ks1; } while (0)
#define SWAIT() asm volatile("s_waitcnt vmcnt(3)" ::: "memory")
#define RESC(a) do { if (MODE == 0) { if (__any((a) < 1.f)) { if (hi == 0) al_l[r32] = (a); asm volatile("s_waitcnt lgkmcnt(0)" ::: "memory"); \
    _Pragma("unroll") for (int d = 0; d < 2; ++d) _Pragma("unroll") for (int r = 0; r < 16; ++r) o[d][r] *= al_l[crow(r, hi)]; } } } while (0)
#define PSM(P0, P1, MN, AL) do { if (MODE == 0) partialSM(P0, P1, m_reg, MN, AL, C, thr); } while (0)
#define FSM(P0, P1, AL, KEY0) do { if (MODE == 0) finishSM(P0, P1, AL, l_reg, pa0, pa1, pa2, pa3); else finishRET(P0, P1, npos, KEY0, hi, lgf, lgb, pre, Lr, pa0, pa1, pa2, pa3); } while (0)
  f32x16 pA0, pA1, pB0, pB1; float mnA = 0, mnB = 0, alA = 1.f, alB = 1.f; bf16x8 pa0, pa1, pa2, pa3; const int NT = seq / KVBLK;
  constexpr int SE = 0, SO = 1;
  SLOAD(SE, 0); asm volatile("s_waitcnt vmcnt(0)" ::: "memory"); SWRITE(0, SE); __syncthreads();
  qkt<ND>(pA0, pA1, K_lds, qr, r32, hi); PSM(pA0, pA1, mnA, alA);
  SLOAD(SO, KVBLK); if (2 < NT) SLOAD(SE, 2 * KVBLK);
  SWAIT(); SWRITE(1, SO); __syncthreads();
  for (int j = 1; j + 1 < NT; j += 2) {
    SBAR(); qkt<ND>(pB0, pB1, (bf16_t*)((char*)K_lds + SHM_K), qr, r32, hi);
    FSM(pA0, pA1, alA, (j - 1) * KVBLK); SBAR();
    SLOAD(SO, (j + 2) * KVBLK); SBAR();
    pv_d0(o, vb0, pa0, pa1, pa2, pa3); PSM(pB0, pB1, mnB, alB);
    __syncthreads(); SWAIT(); SWRITE(0, SE);
    RESC(alB); __syncthreads();
    SBAR(); qkt<ND>(pA0, pA1, K_lds, qr, r32, hi);
    FSM(pB0, pB1, alB, j * KVBLK); SBAR();
    if (j + 3 < NT) SLOAD(SE, (j + 3) * KVBLK); SBAR();
    pv_d0(o, vb0 + (int)SHM_V, pa0, pa1, pa2, pa3); PSM(pA0, pA1, mnA, alA);
    __syncthreads(); SWAIT(); SWRITE(1, SO);
    RESC(alA); __syncthreads();
  }
  SBAR(); qkt<ND>(pB0, pB1, (bf16_t*)((char*)K_lds + SHM_K), qr, r32, hi);
  FSM(pA0, pA1, alA, (NT - 2) * KVBLK); SBAR();
  pv_d0(o, vb0, pa0, pa1, pa2, pa3); PSM(pB0, pB1, mnB, alB);
  __syncthreads(); RESC(alB);
  FSM(pB0, pB1, alB, (NT - 1) * KVBLK); SBAR();
  pv_d0(o, vb0 + (int)SHM_V, pa0, pa1, pa2, pa3);
  if constexpr (MODE == 1) {
    if (Sf != nullptr) {
      __syncthreads();
      *(bf16x8*)((char*)V_lds + vst0) = *reinterpret_cast<const bf16x8*>(Sf + vk * 64 + vc);
      *(bf16x8*)((char*)V_lds + SHM_V + vst0) = *reinterpret_cast<const bf16x8*>(Sb + vk * 64 + vc);
      __syncthreads();
      const float wf = __builtin_amdgcn_exp2f(lgf * (float)(npos + 1)), wb = __builtin_amdgcn_exp2f(lgb * (float)(256 - npos));
#pragma unroll
      for (int dir = 0; dir < 2; ++dir) { const float w = dir ? wb : wf; bf16x8 pq[4];
#pragma unroll
        for (int i = 0; i < 4; ++i) { const u32x4 qw = *reinterpret_cast<const u32x4*>(&qr[i]);
          u32x4 r; r.x = cvtpk(lo16(qw.x) * w, hi16(qw.x) * w); r.y = cvtpk(lo16(qw.y) * w, hi16(qw.y) * w); r.z = cvtpk(lo16(qw.z) * w, hi16(qw.z) * w); r.w = cvtpk(lo16(qw.w) * w, hi16(qw.w) * w);
          pq[i] = *reinterpret_cast<bf16x8*>(&r); }
        pv_d0(o, vb0 + dir * (int)SHM_V, pq[0], pq[1], pq[2], pq[3]); }
    }
  }
  float rli[16];
  if (MODE == 0) {
    if (hi == 0) li_l[r32] = l_reg; asm volatile("s_waitcnt lgkmcnt(0)" ::: "memory");
#pragma unroll
    for (int r = 0; r < 16; ++r) rli[r] = __builtin_amdgcn_rcpf(li_l[crow(r, hi)]);
  } else {
#pragma unroll
    for (int r = 0; r < 16; ++r) rli[r] = 1.f;
  }
  bf16_t* Ow = Ob + (long)(wid * 32) * ldo;
#pragma unroll
  for (int r = 0; r < 16; ++r) { int orow = crow(r, hi);
#pragma unroll
    for (int d0 = 0; d0 < 2; ++d0) Ow[(long)orow * ldo + d0 * 32 + r32] = f2bf(o[d0][r] * rli[r]); }
  __syncthreads();
#undef SLOAD
#undef SWRITE
#undef SWAIT
#undef RESC
#undef PSM
#undef FSM
}
}

__device__ __forceinline__ void tr_tile(const float* W, int ldw, int k0, int srcn0, int nvalid, bf16_t* dst, int ldk, float* tile, int srcn1 = -1) {
  const int tid = opaque_tid();
  if (srcn1 < 0) srcn1 = srcn0 + 32;
#pragma unroll
  for (int i = 0; i < 8; ++i) { const int kk = i * 8 + (tid >> 6), nn = tid & 63; tile[nn * 65 + kk] = nn < nvalid ? W[(size_t)(k0 + kk) * ldw + (nn < 32 ? srcn0 + nn : srcn1 + nn - 32)] : 0.f; }
  __syncthreads();
#pragma unroll
  for (int i = 0; i < 8; ++i) { const int nn = i * 8 + (tid >> 6), kk = tid & 63; dst[(size_t)nn * ldk + kk] = f2bf(tile[nn * 65 + kk]); }
  __syncthreads();
}

__device__ __forceinline__ void phase0(const Params& p, unsigned char* shm) {
  unsigned char* ws = p.ws; const int tid = opaque_tid(), wid = tid >> 6, lane = tid & 63;
  float* fl = (float*)shm;
  for (int it = (int)gridDim.x - 1 - (int)blockIdx.x; it < 192; it += gridDim.x) {
    const int l = it / 96, cg0 = (it % 96) * 64, col = tid & 63, g = tid >> 6;
    const float* wm = p.in[4] + (size_t)l * 1024 * 6144;
    float acc[33];
#pragma unroll
    for (int r = 0; r < 33; ++r) acc[r] = 0.f;
    for (int half = 0; half < 2; ++half) {
      __syncthreads();
      for (int e = tid; e < 33 * 512; e += 512) { const int r = e >> 9, kk = e & 511; const float cv = r < 32 ? p.in[1][r * 1024 + half * 512 + kk] : p.in[3][half * 512 + kk];
        fl[r * 512 + kk] = cv / (1.0f + expf(-cv)); }
      __syncthreads();
      for (int kk = 0; kk < 64; ++kk) { const int kl = g * 64 + kk; const float w = wm[(size_t)(half * 512 + kl) * 6144 + cg0 + col];
#pragma unroll
        for (int r = 0; r < 33; ++r) acc[r] += fl[r * 512 + kl] * w; }
    }
    __syncthreads();
#pragma unroll
    for (int r = 0; r < 33; ++r) fl[(g * 33 + r) * 64 + col] = acc[r];
    __syncthreads();
    for (int e = tid; e < 33 * 64; e += 512) { const int r = e >> 6, cc = e & 63; float s = p.in[5][l * 6144 + cg0 + cc];
#pragma unroll
      for (int gg = 0; gg < 8; ++gg) s += fl[(gg * 33 + r) * 64 + cc];
      ((float*)(ws + WS_MOD))[(size_t)(l * 33 + r) * 6144 + cg0 + cc] = s; }
    __syncthreads();
  }
  for (int it = blockIdx.x; it < 144; it += gridDim.x) {
    const int l = it / 72, r_ = it % 72, which = r_ >= 64, pg = which ? r_ - 64 : r_, L = which ? 256 : 2048;
    float* zs = fl + wid * 64; float* hs = fl + 512 + wid * 256; float* nsum = fl + 512 + 2048;
    const float frq = p.in[17][l * 64 + lane];
    for (int j = 0; j < 4; ++j) {
      const int n = pg * 32 + wid * 4 + j;
      const float tt = (float)n / (float)(L - 1), wpos = 6.283185307179586f * (float)n / (float)L;
      __syncthreads();
      { float z = 0.f;
        if (lane == 0) z = tt;
        else if (lane < 17) { const float fb = 1e-4f + (float)(lane - 1) * ((15.0f - 1e-4f) / 15.0f); z = cosf(fb * wpos); }
        else if (lane < 33) { const float fb = 1e-4f + (float)(lane - 17) * ((15.0f - 1e-4f) / 15.0f); z = -sinf(fb * wpos); }
        zs[lane] = z; }
      __syncthreads();
      float h1;
      { const float* w1 = p.in[11] + l * 33 * 64; float a = p.in[12][l * 64 + lane];
#pragma unroll
        for (int i = 0; i < 33; ++i) a += zs[i] * w1[i * 64 + lane];
        h1 = sinf(frq * a); }
      __syncthreads(); zs[lane] = h1; __syncthreads();
      float h2;
      { const float* w2 = p.in[13] + l * 64 * 64; float a = p.in[14][l * 64 + lane];
#pragma unroll 16
        for (int i = 0; i < 64; ++i) a += zs[i] * w2[i * 64 + lane];
        h2 = sinf(frq * a); }
      __syncthreads(); zs[lane] = h2; __syncthreads();
      { const float* w3 = p.in[15] + l * 64 * 64; float a = p.in[16][l * 64 + lane];
#pragma unroll 16
        for (int i = 0; i < 64; ++i) a += zs[i] * w3[i * 64 + lane];
        hs[j * 64 + lane] = sinf(frq * a); }
    }
    __syncthreads();
    { const float* w4 = p.in[18] + (size_t)l * 64 * 1024; float a[4][16];
#pragma unroll
      for (int j = 0; j < 4; ++j)
#pragma unroll
        for (int m = 0; m < 16; ++m) a[j][m] = 0.f;
#pragma unroll 2
      for (int k = 0; k < 64; ++k) { float wv[16];
#pragma unroll
        for (int m = 0; m < 16; ++m) wv[m] = w4[k * 1024 + m * 64 + lane];
#pragma unroll
        for (int j = 0; j < 4; ++j) { const float hv = hs[j * 64 + k];
#pragma unroll
          for (int m = 0; m < 16; ++m) a[j][m] += hv * wv[m]; } }
      bf16_t* krev = which ? (bf16_t*)(ws + WS_KREVC) + (size_t)l * 512 * 512 : (bf16_t*)(ws + WS_KREVL) + (size_t)l * 512 * 4096;
#pragma unroll
      for (int m = 0; m < 16; ++m) { const int f = m * 64 + lane, o = f >> 9, dir = (f >> 8) & 1, c = f & 255;
        const float delta = -15.350567286626973f + (float)f * ((-3.0701134573253945f + 15.350567286626973f) / 1023.0f);
        float sabs = 0.f;
#pragma unroll
        for (int j = 0; j < 4; ++j) { const int n = pg * 32 + wid * 4 + j; const float tt = (float)n / (float)(L - 1);
          float v = a[j][m] * (expf(-tt * fabsf(delta)) + 0.05f);
          int x = dir ? L + n : L - n;
          if (dir && n == 0) { x = 0; v = 0.f; }
          krev[(size_t)(o * 256 + c) * (2 * L) + x] = f2bf(v); sabs += fabsf(v); }
        nsum[wid * 1024 + f] = sabs; } }
    __syncthreads();
    for (int f = tid; f < 1024; f += 512) { float sm = 0.f;
#pragma unroll
      for (int w = 0; w < 8; ++w) sm += nsum[w * 1024 + f];
      atomicAdd((float*)(ws + WS_NORM) + (l * 2 + which) * 512 + (f >> 9) * 256 + (f & 255), sm); }
    __syncthreads();
  }
  for (int it = blockIdx.x; it < 6144; it += gridDim.x) {
    if (it < 1408) { const int l = it / 704, r = it % 704, nt = r / 16, kt = r % 16; const int n0 = nt * 64, tl = n0 >> 8, t0 = n0 & 255;
      int s0 = 0, s1 = -1, nv = 64; const int bj = t0 >> 7, wa = (t0 & 127) >> 5;
      if (tl < 3) s0 = n0;
      else if (tl == 3) s0 = 768 + t0;
      else if (tl == 4) { s0 = 1024 + t0; nv = t0 < 128 ? 64 : (t0 == 128 ? 32 : 0); if (nv == 0) s0 = 0; }
      else if (tl == 5 || tl == 6 || tl == 9) { const int base = tl == 5 ? 1184 : (tl == 6 ? 1440 : 2208); s0 = base + 64 * wa + 32 * bj; s1 = base + 64 * (wa + 1) + 32 * bj; }
      else if (tl == 7) s0 = 1696 + t0;
      else if (tl == 8) s0 = 1952 + t0;
      else { const int base = wa == 0 ? 2464 : 2592; s0 = base + 32 * bj; s1 = base + 64 + 32 * bj; }
      tr_tile(p.in[8] + (size_t)l * 1024 * INC, INC, kt * 64, s0, nv, (bf16_t*)(ws + WS_WIN) + ((size_t)l * 2816 + n0) * 1024 + kt * 64, 1024, fl, s1); }
    else if (it < 1920) { const int r0 = it - 1408, l = r0 / 256, r = r0 % 256, nt = r / 16, kt = r % 16;
      tr_tile(p.in[29] + (size_t)l * 1024 * 1024, 1024, kt * 64, nt * 64, 64, (bf16_t*)(ws + WS_WOUT) + ((size_t)l * 1024 + nt * 64) * 1024 + kt * 64, 1024, fl); }
    else if (it < 4736) { const int r0 = it - 1920, l = r0 / 1408, r = r0 % 1408, nt = r / 16, kt = r % 16; const int n0 = nt * 64, pn = n0 >> 8, cl = n0 & 255;
      const int src = cl < 128 ? pn * 128 + cl : DFF + pn * 128 + cl - 128;
      tr_tile(p.in[30] + (size_t)l * 1024 * 5632, 5632, kt * 64, src, 64, (bf16_t*)(ws + WS_WFI) + ((size_t)l * 5632 + n0) * 1024 + kt * 64, 1024, fl); }
    else { const int r0 = it - 4736, l = r0 / 704, r = r0 % 704, nt = r / 44, kt = r % 44;
      tr_tile(p.in[31] + (size_t)l * DFF * 1024, 1024, kt * 64, nt * 64, 64, (bf16_t*)(ws + WS_WFO) + ((size_t)l * 1024 + nt * 64) * DFF + kt * 64, DFF, fl); }
  }
  for (size_t e = (size_t)blockIdx.x * 512 + tid; e < (size_t)2 * 1024 * 512; e += (size_t)gridDim.x * 512) {
    const int l = (int)(e >> 19), n = (int)((e >> 9) & 1023), k = (int)(e & 511); float v = 0.f;
    const float* wuq = p.in[21] + (size_t)l * 256 * 384; const float* wukv = p.in[23] + (size_t)l * 128 * 512;
    const float gk_ = k < 256 ? p.in[20][l * 256 + k] : (k < 384 ? p.in[22][l * 128 + k - 256] : 1.0f);
    if (n < 384) { if (k < 256) v = wuq[k * 384 + n] * gk_; }
    else if (n < 768) { const int nn = n - 384, h = nn / 96, d = nn % 96;
      if (d < 64) { if (k >= 256 && k < 384) v = wukv[(k - 256) * 512 + h * 128 + d] * gk_; } else if (k == 384 + d - 64) v = 1.0f; }
    else { const int nn = n - 768, h = nn >> 6, ee = nn & 63; if (k >= 256 && k < 384) v = wukv[(k - 256) * 512 + h * 128 + 64 + ee] * gk_; }
    ((bf16_t*)(ws + WS_WUP))[e] = f2bf(v);
  }
}

__device__ __forceinline__ void norm_phase(const Params& p, int l, int which, bool from_inputs, bool skipctx) {
  const int tid_ = opaque_tid(), wid = tid_ >> 6, lane = tid_ & 63;
  const float* gv = p.in[which ? 7 : 6] + l * 1024;
  const bf16_t* XS = (const bf16_t*)(p.ws + WS_XS); bf16_t* XA = (bf16_t*)(p.ws + WS_XA); const float* MOD = (const float*)(p.ws + WS_MOD);
  for (int r0 = (blockIdx.x * 8 + wid) * 4; r0 < T; r0 += gridDim.x * 32) {
    const int b = r0 / RPB, i0 = r0 - b * RPB;
    if (skipctx && i0 < NCTX) continue;
    const float* md = MOD + ((size_t)(l * 33 + (i0 < NCTX ? 32 : b)) * 6 + which * 3) * 1024;
    if (from_inputs) {
      const float* src = i0 < NCTX ? p.in[2] + ((size_t)b * 256 + i0) * 1024 : p.in[0] + ((size_t)b * 2048 + (i0 - 256)) * 1024;
      f32x4 v[4][4];
#pragma unroll
      for (int u = 0; u < 4; ++u)
#pragma unroll
        for (int q = 0; q < 4; ++q) v[u][q] = *(const f32x4*)(src + (size_t)u * 1024 + q * 256 + lane * 4);
      f32x4 g4[4], sh[4];
#pragma unroll
      for (int q = 0; q < 4; ++q) { const int col = q * 256 + lane * 4; g4[q] = *(const f32x4*)(gv + col); sh[q] = *(const f32x4*)(md + col); const f32x4 sc = *(const f32x4*)(md + 1024 + col);
        g4[q] = g4[q] * (sc + 1.0f); }
#pragma unroll
      for (int u = 0; u < 4; ++u) { float ss = 0.f;
#pragma unroll
        for (int q = 0; q < 4; ++q) ss += v[u][q][0] * v[u][q][0] + v[u][q][1] * v[u][q][1] + v[u][q][2] * v[u][q][2] + v[u][q][3] * v[u][q][3];
        ss = wsum(ss); const float rstd = rsqrtf(ss * (1.0f / 1024.0f) + EPS);
#pragma unroll
        for (int q = 0; q < 4; ++q) { const int col = q * 256 + lane * 4; const f32x4 y = v[u][q] * rstd * g4[q] + sh[q];
          u32x2 w; w.x = cvtpk(y[0], y[1]); w.y = cvtpk(y[2], y[3]); *(u32x2*)(XA + (size_t)(r0 + u) * 1024 + col) = w; } }
    } else {
      u32x4 v[4][2];
#pragma unroll
      for (int u = 0; u < 4; ++u)
#pragma unroll
        for (int q = 0; q < 2; ++q) v[u][q] = *(const u32x4*)(XS + (size_t)(r0 + u) * 1024 + q * 512 + lane * 8);
      f32x4 g4[2][2], sh[2][2];
#pragma unroll
      for (int q = 0; q < 2; ++q)
#pragma unroll
        for (int hf = 0; hf < 2; ++hf) { const int col = q * 512 + lane * 8 + hf * 4; g4[q][hf] = *(const f32x4*)(gv + col); sh[q][hf] = *(const f32x4*)(md + col); const f32x4 sc = *(const f32x4*)(md + 1024 + col);
          g4[q][hf] = g4[q][hf] * (sc + 1.0f); }
#pragma unroll
      for (int u = 0; u < 4; ++u) { f32x4 x[2][2]; float ss = 0.f;
#pragma unroll
        for (int q = 0; q < 2; ++q) { x[q][0] = (f32x4){lo16(v[u][q].x), hi16(v[u][q].x), lo16(v[u][q].y), hi16(v[u][q].y)}; x[q][1] = (f32x4){lo16(v[u][q].z), hi16(v[u][q].z), lo16(v[u][q].w), hi16(v[u][q].w)};
#pragma unroll
          for (int hf = 0; hf < 2; ++hf) ss += x[q][hf][0] * x[q][hf][0] + x[q][hf][1] * x[q][hf][1] + x[q][hf][2] * x[q][hf][2] + x[q][hf][3] * x[q][hf][3]; }
        ss = wsum(ss); const float rstd = rsqrtf(ss * (1.0f / 1024.0f) + EPS);
#pragma unroll
        for (int q = 0; q < 2; ++q) { const f32x4 y0 = x[q][0] * rstd * g4[q][0] + sh[q][0], y1 = x[q][1] * rstd * g4[q][1] + sh[q][1];
          u32x4 w; w.x = cvtpk(y0[0], y0[1]); w.y = cvtpk(y0[2], y0[3]); w.z = cvtpk(y1[0], y1[1]); w.w = cvtpk(y1[2], y1[3]);
          *(u32x4*)(XA + (size_t)(r0 + u) * 1024 + q * 512 + lane * 8) = w; } }
    }
  }
}

__device__ __forceinline__ void rope2(bf16_t* q, float c0, float s0, float c1, float s1, float scale) {
  const unsigned w1 = *(const unsigned*)q, w2 = *(const unsigned*)(q + 32);
  const float x1a = lo16(w1) * scale, x1b = hi16(w1) * scale, x2a = lo16(w2) * scale, x2b = hi16(w2) * scale;
  *(unsigned*)q = cvtpk(x1a * c0 - x2a * s0, x1b * c1 - x2b * s1);
  *(unsigned*)(q + 32) = cvtpk(x2a * c0 + x1a * s0, x2b * c1 + x1b * s1);
}
__device__ __forceinline__ void normrope(bf16_t* q, const float* g, float c0, float s0, float c1, float s1) {
  const unsigned w1 = *(const unsigned*)q, w2 = *(const unsigned*)(q + 32);
  float x1a = lo16(w1), x1b = hi16(w1), x2a = lo16(w2), x2b = hi16(w2);
  const float ss = gsum16(x1a * x1a + x1b * x1b + x2a * x2a + x2b * x2b), rstd = rsqrtf(ss * (1.0f / 64.0f) + EPS);
  x1a *= rstd * g[0]; x1b *= rstd * g[1]; x2a *= rstd * g[32]; x2b *= rstd * g[33];
  *(unsigned*)q = cvtpk(x1a * c0 - x2a * s0, x1b * c1 - x2b * s1);
  *(unsigned*)(q + 32) = cvtpk(x2a * c0 + x1a * s0, x2b * c1 + x1b * s1);
}
__device__ __forceinline__ void prep_phase(const Params& p, int l, unsigned char* shm) {
  const int tid = opaque_tid(), wid = tid >> 6, lane = tid & 63;
  bf16_t* PB = (bf16_t*)(p.ws + WS_PB); const bf16_t* PA = (const bf16_t*)(p.ws + WS_PA);
  const float* gq_mla = p.in[20] + l * 256; const float* gkv = p.in[22] + l * 128;
  const float LT = 13.287712379549449f;
  const float inv8 = exp2f(-(float)(lane & 7) * (LT / 8.0f));
  const f32x4 g4 = *(const f32x4*)(gq_mla + 4 * lane); const float gkv0 = gkv[2 * lane], gkv1 = gkv[2 * lane + 1];
  for (int r0 = (blockIdx.x * 8 + wid) * 4; r0 < T; r0 += gridDim.x * 32) {
    u32x2 cqw[4]; unsigned ckw[4]; bf16_t kr1[4], kr2[4];
#pragma unroll
    for (int u = 0; u < 4; ++u) { const bf16_t* row = PB + (size_t)(r0 + u) * LDPB;
      cqw[u] = *(const u32x2*)(row + C_CQ + 4 * lane); ckw[u] = *(const unsigned*)(row + C_CKV + 2 * lane);
      kr1[u] = row[C_KR + (lane & 15)]; kr2[u] = row[C_KR + 16 + (lane & 15)]; }
#pragma unroll
    for (int u = 0; u < 4; ++u) { const int r = r0 + u; const int b = r / RPB, i = r - b * RPB; const bool lat = i >= NCTX; const int t = i - NCTX;
      const float prow = (float)(t >> 6), pcol = (float)(t & 63);
      bf16_t* row = PB + (size_t)r * LDPB;
      { float x0 = lo16(cqw[u].x), x1 = hi16(cqw[u].x), x2 = lo16(cqw[u].y), x3 = hi16(cqw[u].y);
        const float ss = wsum(x0 * x0 + x1 * x1 + x2 * x2 + x3 * x3), rstd = rsqrtf(ss * (1.0f / 256.0f) + EPS);
        u32x2 w; w.x = cvtpk(x0 * rstd * g4[0], x1 * rstd * g4[1]); w.y = cvtpk(x2 * rstd * g4[2], x3 * rstd * g4[3]); *(u32x2*)(row + C_CQ + 4 * lane) = w; }
      { float x0 = lo16(ckw[u]), x1 = hi16(ckw[u]);
        const float ss = wsum(x0 * x0 + x1 * x1), rstd = rsqrtf(ss * (1.0f / 128.0f) + EPS);
        *(unsigned*)(row + C_CKV + 2 * lane) = cvtpk(x0 * rstd * gkv0, x1 * rstd * gkv1); }
      if (lat && lane < 16) { const float a_ = (lane < 8 ? prow : pcol) * inv8; const float sn = __sinf(a_), cs = __cosf(a_);
        const float x1 = bf2f(kr1[u]), x2 = bf2f(kr2[u]);
        row[C_KR + lane] = f2bf(x1 * cs - x2 * sn); row[C_KR + 16 + lane] = f2bf(x2 * cs + x1 * sn); }
    }
  }
}

constexpr int HY_CS = 5152;
constexpr int HY_UOFF = 8 * HY_CS, HY_RS = 528;
__device__ __forceinline__ void conv16(const bf16_t* P, size_t a, int t0, int L, float w0, float w1, float w2, float bb, float (&y)[16]) {
  const u32x4 q0 = *(const u32x4*)(P + a), q1 = *(const u32x4*)(P + a + 8);
  float r[18];
  r[0] = t0 > 0 ? bf2f(P[a - 1]) : 0.f; r[17] = (t0 + 16 < L) ? bf2f(P[a + 16]) : 0.f;
  r[1] = lo16(q0.x); r[2] = hi16(q0.x); r[3] = lo16(q0.y); r[4] = hi16(q0.y); r[5] = lo16(q0.z); r[6] = hi16(q0.z); r[7] = lo16(q0.w); r[8] = hi16(q0.w);
  r[9] = lo16(q1.x); r[10] = hi16(q1.x); r[11] = lo16(q1.y); r[12] = hi16(q1.y); r[13] = lo16(q1.z); r[14] = hi16(q1.z); r[15] = lo16(q1.w); r[16] = hi16(q1.w);
#pragma unroll
  for (int e = 0; e < 16; ++e) y[e] = w0 * r[e] + w1 * r[e + 1] + w2 * r[e + 2] + bb;
}
template <int TB, bool UCONV>
__device__ __forceinline__ void hy_conv_item(unsigned char* shm, const bf16_t* UT, const bf16_t* XT, bf16_t* OUT, const bf16_t* krev, int L, int off, int tb0, float invnorm, float dskip, int c,
                                             float uw0, float uw1, float uw2, float ub, float xw0_, float xw1_, float xw2_, float xb_) {
  constexpr int RBW = TB / 256;
  const int tid = opaque_tid(), wid = tid >> 6, lane = tid & 63, r32 = lane & 31, hi = lane >> 5;
  bf16_t* G = (bf16_t*)shm; unsigned char* U = shm + HY_UOFF;
  const int glen = TB + L;
  __syncthreads();
  if (tid < glen / 8) { const int y0 = tid * 8, xb = L - tb0 - TB + y0;
    u32x4 cA = (u32x4){0u, 0u, 0u, 0u}, cB = (u32x4){0u, 0u, 0u, 0u};
    if (y0 >= 8 && xb - 8 >= 0 && xb - 8 < 2 * L) cA = *(const u32x4*)(krev + xb - 8);
    if (xb >= 0 && xb < 2 * L) cB = *(const u32x4*)(krev + xb);
    const unsigned C8[8] = {cA.x, cA.y, cA.z, cA.w, cB.x, cB.y, cB.z, cB.w};
#pragma unroll
    for (int a = 0; a < 8; ++a) { unsigned o4[4];
#pragma unroll
      for (int w = 0; w < 4; ++w) { const int e0 = 8 + 2 * w - a;
        if ((a & 1) == 0) o4[w] = C8[e0 >> 1];
        else o4[w] = __builtin_amdgcn_alignbit(C8[(e0 + 1) >> 1], C8[(e0 - 1) >> 1], 16); }
      *(u32x4*)((unsigned char*)G + a * HY_CS + y0 * 2) = (u32x4){o4[0], o4[1], o4[2], o4[3]}; } }
  const bf16_t* Uc = UT + (size_t)c * T + off;
  f32x16 acc[RBW];
#pragma unroll
  for (int i = 0; i < RBW; ++i) acc[i] = f32x16{};
  const int nch = L / 256;
  bf16x8 st[2]; bf16_t pvs[2] = {0, 0}, nxs[2] = {0, 0};
#pragma unroll
  for (int i = 0; i < 2; ++i) { const int q = tid + 512 * i, bb = q >> 5, s8 = (q & 31) * 8; st[i] = *(const bf16x8*)(Uc + (size_t)bb * RPB + s8);
    if (UCONV) { pvs[i] = s8 > 0 ? Uc[(size_t)bb * RPB + s8 - 1] : (bf16_t)0; nxs[i] = (s8 + 8 < L) ? Uc[(size_t)bb * RPB + s8 + 8] : (bf16_t)0; } }
  for (int ch = 0; ch < nch; ++ch) {
    __syncthreads();
#pragma unroll
    for (int i = 0; i < 2; ++i) { const int q = tid + 512 * i, bb = q >> 5, s8 = (q & 31) * 8;
      if (UCONV) { const u32x4 qw = *reinterpret_cast<const u32x4*>(&st[i]);
        const float r[10] = {bf2f(pvs[i]), lo16(qw.x), hi16(qw.x), lo16(qw.y), hi16(qw.y), lo16(qw.z), hi16(qw.z), lo16(qw.w), hi16(qw.w), bf2f(nxs[i])};
        float y[8];
#pragma unroll
        for (int e = 0; e < 8; ++e) y[e] = uw0 * r[e] + uw1 * r[e + 1] + uw2 * r[e + 2] + ub;
        *(u32x4*)(U + bb * HY_RS + s8 * 2) = (u32x4){cvtpk(y[0], y[1]), cvtpk(y[2], y[3]), cvtpk(y[4], y[5]), cvtpk(y[6], y[7])}; }
      else *(bf16x8*)(U + bb * HY_RS + s8 * 2) = st[i]; }
    __syncthreads();
    if (ch + 1 < nch) {
#pragma unroll
      for (int i = 0; i < 2; ++i) { const int q = tid + 512 * i, bb = q >> 5, s8 = (q & 31) * 8, sg = (ch + 1) * 256 + s8; st[i] = *(const bf16x8*)(Uc + (size_t)bb * RPB + sg);
        if (UCONV) { pvs[i] = Uc[(size_t)bb * RPB + sg - 1]; nxs[i] = (sg + 8 < L) ? Uc[(size_t)bb * RPB + sg + 8] : (bf16_t)0; } } }
#pragma unroll 4
    for (int ks = 0; ks < 16; ++ks) {
      const int sl = ks * 16 + 8 * hi;
      const bf16x8 bfrag = *(const bf16x8*)(U + r32 * HY_RS + sl * 2);
#pragma unroll
      for (int i = 0; i < RBW; ++i) { const int rb = wid * RBW + i; const int y0 = TB - rb * 32 - (r32 & ~7) + ch * 256 + sl;
        const bf16x8 afrag = *(const bf16x8*)((const unsigned char*)G + (r32 & 7) * HY_CS + y0 * 2);
        acc[i] = __builtin_amdgcn_mfma_f32_32x32x16_bf16(afrag, bfrag, acc[i], 0, 0, 0); }
    }
  }
  float* patch = (float*)(shm + 65536) + wid * (32 * 33);
  const int eb = lane >> 1, eh = (lane & 1) * 16;
#pragma unroll
  for (int i = 0; i < RBW; ++i) { const int rb = wid * RBW + i;
#pragma unroll
    for (int r = 0; r < 16; ++r) patch[att::crow(r, hi) * 33 + r32] = acc[i][r];
    asm volatile("s_waitcnt lgkmcnt(0)" ::: "memory");
    const size_t a = (size_t)c * T + (size_t)eb * RPB + off + tb0 + rb * 32 + eh;
    const int t0e = tb0 + rb * 32 + eh;
    float xv[16], uv[16];
    conv16(XT, a, t0e, L, xw0_, xw1_, xw2_, xb_, xv);
    if (UCONV) conv16(UT, a, t0e, L, uw0, uw1, uw2, ub, uv);
    else { const u32x4 u0 = *(const u32x4*)(UT + a), u1 = *(const u32x4*)(UT + a + 8);
      uv[0] = lo16(u0.x); uv[1] = hi16(u0.x); uv[2] = lo16(u0.y); uv[3] = hi16(u0.y); uv[4] = lo16(u0.z); uv[5] = hi16(u0.z); uv[6] = lo16(u0.w); uv[7] = hi16(u0.w);
      uv[8] = lo16(u1.x); uv[9] = hi16(u1.x); uv[10] = lo16(u1.y); uv[11] = hi16(u1.y); uv[12] = lo16(u1.z); uv[13] = hi16(u1.z); uv[14] = lo16(u1.w); uv[15] = hi16(u1.w); }
    float cv[16];
#pragma unroll
    for (int e = 0; e < 16; ++e) cv[e] = patch[(eh + e) * 33 + eb];
    unsigned ow[8];
#pragma unroll
    for (int e = 0; e < 8; ++e) ow[e] = cvtpk(xv[2 * e] * (cv[2 * e] * invnorm + uv[2 * e] * dskip), xv[2 * e + 1] * (cv[2 * e + 1] * invnorm + uv[2 * e + 1] * dskip));
    *(u32x4*)(OUT + a) = (u32x4){ow[0], ow[1], ow[2], ow[3]}; *(u32x4*)(OUT + a + 8) = (u32x4){ow[4], ow[5], ow[6], ow[7]};
    asm volatile("s_waitcnt lgkmcnt(0)" ::: "memory");
  }
}
__device__ __forceinline__ void hy_order_items(const Params& p, int l, int order, int it, unsigned char* shm) {
  const bf16_t* UT = (const bf16_t*)(p.ws + (order == 0 ? WS_VT : WS_ZZT)); const bf16_t* XT = (const bf16_t*)(p.ws + (order == 0 ? WS_X1T : WS_X2T));
  bf16_t* OUT = (bf16_t*)(p.ws + (order == 0 ? WS_ZZT : WS_YAT));
  const float* NORM = (const float*)(p.ws + WS_NORM);
  const bool lat = it < 1024; const int slot_ = (it & 255) >> 3; const int c = lat ? ((it >> 8) * 8 + (it & 7)) * 8 + (slot_ >> 2) : it - 1024, tb = slot_ & 3;
  const float* cw = p.in[9] + l * 3 * 768; const float* cb = p.in[10] + l * 768; const int xs = (order == 0 ? 256 : 512) + c;
  const float u0 = cw[c], u1 = cw[768 + c], u2 = cw[1536 + c], ub = cb[c], x0 = cw[xs], x1 = cw[768 + xs], x2 = cw[1536 + xs], xb = cb[xs];
  const float dsk = p.in[19][l * 512 + order * 256 + c];
  if (lat) { const bf16_t* krev = (const bf16_t*)(p.ws + WS_KREVL) + ((size_t)l * 512 + order * 256 + c) * 4096; const float inn = 1.0f / NORM[(l * 2 + 0) * 512 + order * 256 + c];
    if (order == 0) hy_conv_item<512, true>(shm, UT, XT, OUT, krev, 2048, 256, tb * 512, inn, dsk, c, u0, u1, u2, ub, x0, x1, x2, xb);
    else hy_conv_item<512, false>(shm, UT, XT, OUT, krev, 2048, 256, tb * 512, inn, dsk, c, u0, u1, u2, ub, x0, x1, x2, xb); }
  else { const bf16_t* krev = (const bf16_t*)(p.ws + WS_KREVC) + ((size_t)l * 512 + order * 256 + c) * 512; const float inn = 1.0f / NORM[(l * 2 + 1) * 512 + order * 256 + c];
    if (order == 0) hy_conv_item<256, true>(shm, UT, XT, OUT, krev, 256, 0, 0, inn, dsk, c, u0, u1, u2, ub, x0, x1, x2, xb);
    else hy_conv_item<256, false>(shm, UT, XT, OUT, krev, 256, 0, 0, inn, dsk, c, u0, u1, u2, ub, x0, x1, x2, xb); }
}


__device__ __forceinline__ float log2_sigmoid(float x) { return -log1pf(expf(-x)) * 1.4426950408889634f; }
__device__ __forceinline__ void ret_state_item(const Params& p, int l, int it, unsigned char* shm) {
  const int tid = opaque_tid(), wid = tid >> 6, lane = tid & 63, r32 = lane & 31, hi = lane >> 5;
  const int b = it >> 3, h = (it >> 1) & 3, dir = it & 1;
  const bf16_t* PB = (const bf16_t*)(p.ws + WS_PB);
  const bf16_t* Kh = PB + (size_t)b * RPB * LDPB + C_RK + h * 64; const bf16_t* Vh = PB + (size_t)b * RPB * LDPB + C_RV + h * 64;
  bf16_t* ST = (bf16_t*)(p.ws + WS_RST) + (size_t)((b * 4 + h) * 2 + dir) * 8 * 4096;
  const float lg = log2_sigmoid(p.in[24][l * 8 + dir * 4 + h]);
  const int vk = tid >> 3, vc = (tid & 7) * 8, vst0 = att::v_st(vk, vc);
  char* K_l = (char*)shm; char* V_l = (char*)shm + 8192;
  const int kb = (int)(uintptr_t)K_l + att::v_rd_base(lane), vb = (int)(uintptr_t)V_l + att::v_rd_base(lane);
  const float wk = __builtin_amdgcn_exp2f(lg * (float)(dir ? vk : 63 - vk)), dec64 = __builtin_amdgcn_exp2f(lg * 64.0f);
  const int db = (wid >> 1) & 1, eb = wid & 1;
  f32x16 acc = f32x16{};
  auto rowtile = [&](int s) { return dir ? (s < 4 ? 3 - s : 39 - s) : s; };
  bf16x8 kreg, vreg;
  { const int rt = rowtile(0); kreg = *reinterpret_cast<const bf16x8*>(Kh + (size_t)(rt * 64 + vk) * LDPB + vc); vreg = *reinterpret_cast<const bf16x8*>(Vh + (size_t)(rt * 64 + vk) * LDPB + vc); }
  const int nsteps = dir ? 32 : 32;
  for (int s_ = 0; s_ < nsteps; ++s_) {
    __syncthreads();
    { const u32x4 kw = *reinterpret_cast<const u32x4*>(&kreg); u32x4 r;
      r.x = cvtpk(lo16(kw.x) * wk, hi16(kw.x) * wk); r.y = cvtpk(lo16(kw.y) * wk, hi16(kw.y) * wk); r.z = cvtpk(lo16(kw.z) * wk, hi16(kw.z) * wk); r.w = cvtpk(lo16(kw.w) * wk, hi16(kw.w) * wk);
      *(u32x4*)(K_l + vst0) = r; *(bf16x8*)(V_l + vst0) = vreg; }
    __syncthreads();
    if (s_ + 1 < nsteps) { const int rt = rowtile(s_ + 1); kreg = *reinterpret_cast<const bf16x8*>(Kh + (size_t)(rt * 64 + vk) * LDPB + vc); vreg = *reinterpret_cast<const bf16x8*>(Vh + (size_t)(rt * 64 + vk) * LDPB + vc); }
    if (wid < 4) {
#pragma unroll
      for (int r = 0; r < 16; ++r) acc[r] *= dec64;
#define PKV2(L, H) (bf16x8){L[0], L[1], L[2], L[3], H[0], H[1], H[2], H[3]}
#define ST_STEP(KS) do { const s16x4 al = db ? att::tr_read<att::v_rd_off(1, KS, 0)>(kb) : att::tr_read<att::v_rd_off(0, KS, 0)>(kb), ah = db ? att::tr_read<att::v_rd_off(1, KS, 1)>(kb) : att::tr_read<att::v_rd_off(0, KS, 1)>(kb); \
        const s16x4 bl = eb ? att::tr_read<att::v_rd_off(1, KS, 0)>(vb) : att::tr_read<att::v_rd_off(0, KS, 0)>(vb), bh = eb ? att::tr_read<att::v_rd_off(1, KS, 1)>(vb) : att::tr_read<att::v_rd_off(0, KS, 1)>(vb); \
        asm volatile("s_waitcnt lgkmcnt(0)" ::: "memory"); __builtin_amdgcn_sched_barrier(0); \
        acc = __builtin_amdgcn_mfma_f32_32x32x16_bf16(PKV2(al, ah), PKV2(bl, bh), acc, 0, 0, 0); } while (0)
      ST_STEP(0); ST_STEP(1); ST_STEP(2); ST_STEP(3);
#undef ST_STEP
#undef PKV2
      int qb = -1;
      if (!dir) { if (((s_ + 1) & 3) == 0) qb = (s_ + 1) / 4 - 1; }
      else { if (s_ == 3) qb = 7; else if (s_ > 3) { const int rt = 39 - s_; if (((rt - 4) & 3) == 0 && rt >= 8) qb = (rt - 4) / 4 - 1; } }
      if (qb >= 0 && qb < 8) { bf16_t* dst = ST + (size_t)qb * 4096;
#pragma unroll
        for (int r = 0; r < 16; ++r) dst[(att::crow(r, hi) + 32 * db) * 64 + 32 * eb + r32] = f2bf(acc[r]); }
    }
  }
  __syncthreads();
}

__device__ __forceinline__ void attn_item(const Params& p, int l, int kind, int it, unsigned char* shm) {
  bf16_t* PB = (bf16_t*)(p.ws + WS_PB); bf16_t* UM = (bf16_t*)(p.ws + WS_XA);
  const bool lat = it < 1024; int b, h, qb;
  if (lat) { const int k_ = it >> 8, x_ = it & 7, slot = (it & 255) >> 3; b = k_ * 8 + x_; h = slot >> 3; qb = slot & 7; }
  else { const int j = it - 1024; b = j >> 2; h = j & 3; qb = 0; }
  const size_t krow0 = (size_t)b * RPB, qrow0 = krow0 + (lat ? 256 + qb * 256 : 0);
  const int seq = lat ? RPB : NCTX;
  const float L2E = 1.4426950408889634f;
  if (kind == 0) {
    bf16_t* Q = PB + qrow0 * LDPB + C_GQ + h * 64; const bf16_t* K = PB + krow0 * LDPB + C_GK + (h >> 1) * 64; const bf16_t* V = PB + krow0 * LDPB + C_GV + (h >> 1) * 64;
    att::attn_body<64, 0, false>(Q, LDPB, K, V, LDPB, Q, LDPB, seq, (char*)shm, 0.125f * L2E, 8.0f / 0.125f, qb * 256, 0.f, 0.f, 0, 0);
  } else if (kind == 1) {
    bf16_t* Q = PB + qrow0 * LDPB + C_RQ + h * 64; const bf16_t* K = PB + qrow0 * LDPB + C_RK + h * 64; const bf16_t* V = PB + qrow0 * LDPB + C_RV + h * 64;
    const float lgf = log2_sigmoid(p.in[24][l * 8 + h]), lgb = log2_sigmoid(p.in[24][l * 8 + 4 + h]);
    const bf16_t* ST = (const bf16_t*)(p.ws + WS_RST) + (size_t)(b * 4 + h) * 2 * 8 * 4096;
    att::attn_body<64, 1, false>(Q, LDPB, K, V, LDPB, Q, LDPB, 256, (char*)shm, 1.f, 0.f, 0, lgf, lgb, 0, 256, lat ? ST + (size_t)qb * 4096 : nullptr, lat ? ST + (size_t)(8 + qb) * 4096 : nullptr);
  } else {
    bf16_t* Q = UM + qrow0 * LDU + h * 96; const bf16_t* K = UM + krow0 * LDU + 384 + h * 96; const bf16_t* V = UM + krow0 * LDU + 768 + h * 64;
    const float sc = 0.10206207261596577f;
    if (lat) att::attn_body<96, 0, true>(Q, LDU, K, V, LDU, Q, LDU, seq, (char*)shm, sc * L2E, 8.0f / sc, qb * 256, 0.f, 0.f, 0, 0);
    else att::attn_body<96, 0, false>(Q, LDU, K, V, LDU, Q, LDU, seq, (char*)shm, sc * L2E, 8.0f / sc, 0, 0.f, 0.f, 0, 0);
  }
}

__device__ __forceinline__ void merge_phase(const Params& p, int l, bool with_ctx, unsigned char* shm) {
  const int tid = opaque_tid(), wid = tid >> 6, lane = tid & 63;
  const bf16_t* PB = (const bf16_t*)(p.ws + WS_PB); const bf16_t* YAT = (const bf16_t*)(p.ws + WS_YAT); bf16_t* XA = (bf16_t*)(p.ws + WS_XA);
  const float* go = p.in[28] + l * 1024; const float* grn = p.in[25] + l * 256;
  bf16_t* tileT = (bf16_t*)shm;
  for (int tile = blockIdx.x; tile < T / 64; tile += gridDim.x) {
    const int r0 = tile * 64, i0 = r0 % RPB;
    if (!with_ctx && i0 < NCTX) continue;
    __syncthreads();
#pragma unroll
    for (int i = 0; i < 4; ++i) { const int q = tid + 512 * i, c = q >> 3, rc = (q & 7) * 8; const bf16x8 v = *(const bf16x8*)(YAT + (size_t)c * T + r0 + rc);
#pragma unroll
      for (int e = 0; e < 8; ++e) tileT[(rc + e) * 264 + c] = (bf16_t)v[e]; }
    __syncthreads();
    const f32x4 g0 = *(const f32x4*)(go + 4 * lane), g1 = *(const f32x4*)(go + 256 + 4 * lane), g2 = *(const f32x4*)(go + 512 + 4 * lane), g3 = *(const f32x4*)(go + 768 + 4 * lane);
    const f32x4 grn4 = *(const f32x4*)(grn + 4 * lane);
#pragma unroll 1
    for (int half = 0; half < 2; ++half) {
      u32x2 wa[4], wb[4], wc[4], wg[4], wd[4];
#pragma unroll
      for (int u = 0; u < 4; ++u) { const int rl = wid * 8 + half * 4 + u; const size_t r = (size_t)r0 + rl;
        wa[u] = *(const u32x2*)(tileT + rl * 264 + 4 * lane);
        wb[u] = *(const u32x2*)(XA + r * LDU + (lane >> 4) * 96 + (lane & 15) * 4);
        wc[u] = *(const u32x2*)(PB + r * LDPB + C_RQ + 4 * lane); wg[u] = *(const u32x2*)(PB + r * LDPB + C_RG + 4 * lane);
        wd[u] = *(const u32x2*)(PB + r * LDPB + C_GQ + 4 * lane); }
#pragma unroll
      for (int u = 0; u < 4; ++u) { const int rl = wid * 8 + half * 4 + u; const size_t r = (size_t)r0 + rl;
        float ya[4] = {lo16(wa[u].x), hi16(wa[u].x), lo16(wa[u].y), hi16(wa[u].y)}, yb[4] = {lo16(wb[u].x), hi16(wb[u].x), lo16(wb[u].y), hi16(wb[u].y)};
        float yc[4] = {lo16(wc[u].x), hi16(wc[u].x), lo16(wc[u].y), hi16(wc[u].y)}, yd[4] = {lo16(wd[u].x), hi16(wd[u].x), lo16(wd[u].y), hi16(wd[u].y)};
        const float gg[4] = {lo16(wg[u].x), hi16(wg[u].x), lo16(wg[u].y), hi16(wg[u].y)};
        { const float ss = gsum16(yc[0] * yc[0] + yc[1] * yc[1] + yc[2] * yc[2] + yc[3] * yc[3]), rstd = rsqrtf(ss * (1.0f / 64.0f) + EPS);
#pragma unroll
          for (int j = 0; j < 4; ++j) yc[j] = yc[j] * rstd * grn4[j] * (gg[j] * __builtin_amdgcn_rcpf(1.0f + __expf(-gg[j]))); }
        float sa = ya[0] * ya[0] + ya[1] * ya[1] + ya[2] * ya[2] + ya[3] * ya[3], sb = yb[0] * yb[0] + yb[1] * yb[1] + yb[2] * yb[2] + yb[3] * yb[3];
        float sc = yc[0] * yc[0] + yc[1] * yc[1] + yc[2] * yc[2] + yc[3] * yc[3], sd = yd[0] * yd[0] + yd[1] * yd[1] + yd[2] * yd[2] + yd[3] * yd[3];
        sa = wsum(sa); sb = wsum(sb); sc = wsum(sc); sd = wsum(sd);
        const float ra = rsqrtf(sa * (1.0f / 256.0f) + EPS), rb = rsqrtf(sb * (1.0f / 256.0f) + EPS), rc_ = rsqrtf(sc * (1.0f / 256.0f) + EPS), rd = rsqrtf(sd * (1.0f / 256.0f) + EPS);
        u32x2 w; bf16_t* orow = XA + r * 1024 + 4 * lane;
        w.x = cvtpk(ya[0] * ra * g0[0], ya[1] * ra * g0[1]); w.y = cvtpk(ya[2] * ra * g0[2], ya[3] * ra * g0[3]); *(u32x2*)(orow) = w;
        w.x = cvtpk(yb[0] * rb * g1[0], yb[1] * rb * g1[1]); w.y = cvtpk(yb[2] * rb * g1[2], yb[3] * rb * g1[3]); *(u32x2*)(orow + 256) = w;
        w.x = cvtpk(yc[0] * rc_ * g2[0], yc[1] * rc_ * g2[1]); w.y = cvtpk(yc[2] * rc_ * g2[2], yc[3] * rc_ * g2[3]); *(u32x2*)(orow + 512) = w;
        w.x = cvtpk(yd[0] * rd * g3[0], yd[1] * rd * g3[1]); w.y = cvtpk(yd[2] * rd * g3[2], yd[3] * rd * g3[3]); *(u32x2*)(orow + 768) = w; }
    }
  }
}

__device__ __forceinline__ void final_phase(const Params& p) {
  const int tid_ = opaque_tid(), wid = tid_ >> 6, lane = tid_ & 63;
  const bf16_t* XS = (const bf16_t*)(p.ws + WS_XS); const float* gv = p.in[32];
  f32x4 g4[2][2];
#pragma unroll
  for (int q = 0; q < 2; ++q)
#pragma unroll
    for (int hf = 0; hf < 2; ++hf) g4[q][hf] = *(const f32x4*)(gv + q * 512 + lane * 8 + hf * 4);
  for (int q0 = (blockIdx.x * 8 + wid) * 4; q0 < NB * SEQ; q0 += gridDim.x * 32) {
    const int b = q0 >> 11, t = q0 & 2047; const bf16_t* src = XS + ((size_t)b * RPB + 256 + t) * 1024; float* dst = p.out + (size_t)q0 * 1024;
    u32x4 v[4][2];
#pragma unroll
    for (int u = 0; u < 4; ++u)
#pragma unroll
      for (int q = 0; q < 2; ++q) v[u][q] = *(const u32x4*)(src + (size_t)u * 1024 + q * 512 + lane * 8);
#pragma unroll
    for (int u = 0; u < 4; ++u) { f32x4 x[2][2]; float ss = 0.f;
#pragma unroll
      for (int q = 0; q < 2; ++q) { x[q][0] = (f32x4){lo16(v[u][q].x), hi16(v[u][q].x), lo16(v[u][q].y), hi16(v[u][q].y)}; x[q][1] = (f32x4){lo16(v[u][q].z), hi16(v[u][q].z), lo16(v[u][q].w), hi16(v[u][q].w)};
#pragma unroll
        for (int hf = 0; hf < 2; ++hf) ss += x[q][hf][0] * x[q][hf][0] + x[q][hf][1] * x[q][hf][1] + x[q][hf][2] * x[q][hf][2] + x[q][hf][3] * x[q][hf][3]; }
      ss = wsum(ss); const float rstd = rsqrtf(ss * (1.0f / 1024.0f) + EPS);
#pragma unroll
      for (int q = 0; q < 2; ++q)
#pragma unroll
        for (int hf = 0; hf < 2; ++hf) *(f32x4*)(dst + (size_t)u * 1024 + q * 512 + lane * 8 + hf * 4) = x[q][hf] * rstd * g4[q][hf]; }
  }
}

__global__ void __launch_bounds__(512, 2) mega(Params p) {
  extern __shared__ __attribute__((aligned(16))) unsigned char shm[];
  cg::grid_group grid = cg::this_grid();
  LAS unsigned char* lds3 = (LAS unsigned char*)shm;
  unsigned char* ws = p.ws;
  const int G = gridDim.x, c = blockIdx.x;
  volatile LAS unsigned* xbst = (volatile LAS unsigned*)(lds3 + 131072);
  if (threadIdx.x == 0) { xbst[0] = 0u; xbst[1] = 0u; xbst[2] = 0u; xbst[3] = 0u; }
  __syncthreads();
  (void)xcd_barrier_post((unsigned*)(ws + WS_BAR), xbst);
#define XBAR() do { XcdBarrier b_; b_.bar = (unsigned*)(p.ws + WS_BAR); b_.x = xb_xcc_id(); b_.st = (volatile LAS unsigned*)(lds3 + 131072); xcd_barrier(b_); } while (0)
  phase0(p, shm);
  if (p.ws == nullptr) grid.sync();
  XBAR();
#pragma unroll 1
  for (int l = 0; l < 2; ++l) {
    const bool l0 = (l == 0);
    norm_phase(p, l, 0, l0, false);
    XBAR();
    { pg8::Gemm g{(const bf16_t*)(ws + WS_XA), (const bf16_t*)(ws + WS_WIN) + (size_t)l * 2816 * 1024, 1024, 2816, 1024};
      pg8::Sched S; if (l0) S.init(T / 256, 2816, G, c, 0); else S.init(256, 2816, G, c, 1, 32 * 5);
      pg8::EpiWin E{(bf16_t*)(ws + WS_PA), (bf16_t*)(ws + WS_PB), p.in[26] + l * 64, p.in[27] + l * 64, (bf16_t*)(ws + WS_VT), shm + LDS_TP, (float*)(ws + WS_SSQ), (float*)(ws + WS_SSK)};
      pg8::gemm_phase(lds3, g, S, E); }
    XBAR();
    { pg8::Gemm g{(const bf16_t*)(ws + WS_PB), (const bf16_t*)(ws + WS_WUP) + (size_t)l * 1024 * 512, LDPB, 1024, 512};
      pg8::Sched S; S.init(T / 256, 1024, G, c, 0);
      pg8::EpiBf E{(bf16_t*)(ws + WS_XA), LDU, (const float*)(ws + WS_SSQ), (const float*)(ws + WS_SSK)};
      pg8::gemm_phase(lds3, g, S, E); }
    { const int nat = l0 ? 1152 : 1024, nhy = l0 ? 1280 : 1024, tot = nat + 256 + nhy;
      for (int it = c; it < tot; it += G) {
        if (it < 256) ret_state_item(p, l, it, shm);
        else if (it < 256 + nat) attn_item(p, l, 0, it - 256, shm);
        else hy_order_items(p, l, 0, it - 256 - nat, shm);
      } }
    XBAR();
    { const int nat = l0 ? 1152 : 1024, nhy = l0 ? 1280 : 1024, tot = 2 * nat + nhy;
      for (int it = c; it < tot; it += G) {
        if (it < nat) attn_item(p, l, 2, it, shm);
        else if (it < 2 * nat) attn_item(p, l, 1, it - nat, shm);
        else hy_order_items(p, l, 1, it - 2 * nat, shm);
      } }
    XBAR();
    merge_phase(p, l, l0, shm);
    XBAR();
    { pg8::Gemm g{(const bf16_t*)(ws + WS_XA), (const bf16_t*)(ws + WS_WOUT) + (size_t)l * 1024 * 1024, 1024, 1024, 1024};
      pg8::Sched S; S.init(l0 ? T / 256 : 256, 1024, G, c, l0 ? 0 : 1);
      pg8::EpiRes E{p.in[0], p.in[2], (bf16_t*)(ws + WS_XS), (const float*)(ws + WS_MOD) + ((size_t)l * 33 * 6 + 2) * 1024, l0 ? 1 : 0};
      pg8::gemm_phase(lds3, g, S, E); }
    XBAR();
    norm_phase(p, l, 1, false, !l0);
    XBAR();
    { pg8::Gemm g{(const bf16_t*)(ws + WS_XA), (const bf16_t*)(ws + WS_WFI) + (size_t)l * 5632 * 1024, 1024, 5632, 1024};
      pg8::Sched S; S.init(l0 ? T / 256 : 256, 5632, G, c, l0 ? 0 : 1);
      pg8::EpiSwiglu E{(bf16_t*)(ws + WS_H)};
      pg8::gemm_phase(lds3, g, S, E); }
    XBAR();
    { pg8::Gemm g{(const bf16_t*)(ws + WS_H), (const bf16_t*)(ws + WS_WFO) + (size_t)l * 1024 * DFF, DFF, 1024, DFF};
      pg8::Sched S; S.init(l0 ? T / 256 : 256, 1024, G, c, l0 ? 0 : 1);
      pg8::EpiRes E{p.in[0], p.in[2], (bf16_t*)(ws + WS_XS), (const float*)(ws + WS_MOD) + ((size_t)l * 33 * 6 + 5) * 1024, 0};
      pg8::gemm_phase(lds3, g, S, E); }
    XBAR();
  }
  final_phase(p);
}

extern "C" void kernel_launch(void* const* d_in, const int* in_sizes, int n_in, void* d_out, int out_size, void* d_ws, size_t ws_size, hipStream_t stream) {
  static int grid_blocks = 0;
  if (grid_blocks == 0) {
    if (n_in != 33 || ws_size < WS_END) { fprintf(stderr, "kernel_launch: need 33 inputs and %zu bytes of workspace (got %d, %zu)\n", (size_t)WS_END, n_in, ws_size); grid_blocks = -1; return; }
    int dev = 0, cus = 0, per_cu = 0;
    (void)hipGetDevice(&dev);
    (void)hipDeviceGetAttribute(&cus, hipDeviceAttributeMultiprocessorCount, dev);
    if (hipFuncSetAttribute((const void*)mega, hipFuncAttributeMaxDynamicSharedMemorySize, LDS_BYTES) != hipSuccess) { fprintf(stderr, "kernel_launch: hipFuncSetAttribute failed\n"); grid_blocks = -1; return; }
    if (hipOccupancyMaxActiveBlocksPerMultiprocessor(&per_cu, (const void*)mega, 512, LDS_BYTES) != hipSuccess || per_cu < 1) { fprintf(stderr, "kernel_launch: occupancy query gave %d\n", per_cu); per_cu = 1; }
    (void)hipGetLastError();
    grid_blocks = cus * 1;
  }
  if (grid_blocks < 0) return;
  (void)hipMemsetAsync((char*)d_ws + WS_NORM, 0, WS_KREVL - WS_NORM, stream);
  Params p{};
  for (int i = 0; i < 33; ++i) p.in[i] = (const float*)d_in[i];
  p.out = (float*)d_out; p.ws = (unsigned char*)d_ws;
  void* args[] = {&p};
  hipError_t e = hipLaunchCooperativeKernel((const void*)mega, dim3(grid_blocks), dim3(512), args, LDS_BYTES, stream);
  if (e != hipSuccess) fprintf(stderr, "cooperative launch failed: %s (grid %d)\n", hipGetErrorString(e), grid_blocks);
}
```
